# Optimizing an MI355X kernel written in HIP

```python
import jax, jax.numpy as jnp
from jax import lax
import numpy as np

D_MODEL = 1024
BATCH = 8
SEQ = 8192
DEPTH = 2

GRID_W = 64
CTX_LEN = 256
N_BRANCH = 3
MIX_W = 512
HEAD_DIM = 64
N_HEADS = MIX_W // HEAD_DIM
CONV_WIDTH = 3
D_DECAY_LORA = 64
D_AAA_LORA = 64
D_GATE_LORA = 128
NA_ROWS = 8
NA_COLS = 16
D_FF = -(-(8 * D_MODEL) // (3 * 256)) * 256
ROPE_THETA = 10000.0
EPS = 1e-6
LN_X_EPS = 64e-5
NEG_INF = -1e30

C_CONV = 3 * MIX_W
C_RWKV = 3 * MIX_W + D_DECAY_LORA + D_AAA_LORA
C_ATTN = 3 * MIX_W
C_GATE = N_BRANCH * D_MODEL
D_IN = C_CONV + C_RWKV + D_GATE_LORA + C_ATTN + C_GATE
IN_SPLITS = [C_CONV, C_CONV + C_RWKV, C_CONV + C_RWKV + D_GATE_LORA, C_CONV + C_RWKV + D_GATE_LORA + C_ATTN]
RWKV_SPLITS = [MIX_W, 2 * MIX_W, 3 * MIX_W, 3 * MIX_W + D_DECAY_LORA]

kernel_name = 'hybrid_conv_rwkv7_natten_dit'


def rms_norm(x, g):
    xf = x.astype(jnp.float32)
    y = xf * lax.rsqrt(jnp.mean(xf * xf, axis=-1, keepdims=True) + EPS)
    return (y * g.astype(jnp.float32)).astype(x.dtype)


def heads(t):
    return t.reshape(t.shape[:-1] + (N_HEADS, HEAD_DIM))


def shift_seq(z, offset):
    if offset == 1:
        return jnp.pad(z[:, :-1], ((0, 0), (1, 0), (0, 0)))
    return jnp.pad(z[:, 1:], ((0, 0), (0, 1), (0, 0)))


def short_conv_mixer(u, conv_w):
    b_gate, c_gate, h = jnp.split(u, 3, axis=-1)
    z = c_gate * h
    zc = conv_w[0] * shift_seq(z, 1) + conv_w[1] * z + conv_w[2] * shift_seq(z, -1)
    return b_gate * zc


def rwkv_scan_inputs(z, mu, w0, w2, a0, a2, k_k, k_a):
    f32 = jnp.float32
    per_dir = []
    for d, offset in enumerate((1, -1)):
        zd = z + mu[d] * (shift_seq(z, offset) - z)
        r, k, v, lw, la = jnp.split(zd, RWKV_SPLITS, axis=-1)
        w_log = -jax.nn.softplus(-(w0[d] + jnp.tanh(lw) @ w2[d])) - 0.5
        decay = jnp.exp(-jnp.exp(w_log.astype(f32)))
        a = jax.nn.sigmoid(a0[d] + la @ a2[d])
        kk = heads(k * k_k).astype(f32)
        kk = kk * lax.rsqrt(jnp.maximum(jnp.sum(kk * kk, axis=-1, keepdims=True), 1e-24))
        k = k * (1.0 + (a - 1.0) * k_a)
        seqs = [heads(t).astype(f32) for t in (r, decay, k, v)] + [-kk, kk * heads(a).astype(f32)]
        if d == 1:
            seqs = [jnp.flip(t, axis=1) for t in seqs]
        per_dir.append(seqs)
    return [jnp.stack(pair, axis=0).transpose(2, 0, 1, 3, 4) for pair in zip(*per_dir)]


def wkv_scan(state0, xs, emit):
    def step(S, inp):
        r, w, k, v, a, b = inp
        sa = jnp.einsum('dbhij,dbhj->dbhi', S, a)
        S = S * w[..., None, :] + sa[..., :, None] * b[..., None, :] + v[..., :, None] * k[..., None, :]
        y = jnp.einsum('dbhij,dbhj->dbhi', S, r) if emit else None
        return S, y
    return lax.scan(step, state0, tuple(xs))


def merge_dirs(t):
    return t[:, 0] + jnp.flip(t[:, 1], axis=0)


def rwkv_readout(ys, xs, lg, r_k, g2, lnx_g, lnx_b):
    f32 = jnp.float32
    r, k, v = xs[0], xs[2], xs[3]
    y = merge_dirs(ys)
    bonus = merge_dirs(jnp.sum(r * k * r_k.astype(f32), axis=-1, keepdims=True) * v)
    mean = jnp.mean(y, axis=-1, keepdims=True)
    var = jnp.mean(jnp.square(y - mean), axis=-1, keepdims=True)
    y = (y - mean) * lax.rsqrt(var + LN_X_EPS) * heads(lnx_g).astype(f32) + heads(lnx_b).astype(f32) + bonus
    T, B = y.shape[0], y.shape[1]
    y = y.transpose(1, 0, 2, 3).reshape(B, T, MIX_W).astype(lg.dtype)
    return y * (jax.nn.sigmoid(lg) @ g2)


def axial_rope(x, row, col):
    def rotate(xp, pos):
        half = xp.shape[-1] // 2
        freqs = ROPE_THETA ** (-jnp.arange(half, dtype=jnp.float32) / half)
        ang = pos.astype(jnp.float32)[:, None] * freqs
        cos, sin = jnp.cos(ang)[None, :, None, :], jnp.sin(ang)[None, :, None, :]
        x1, x2 = jnp.split(xp.astype(jnp.float32), 2, axis=-1)
        return jnp.concatenate([x1 * cos - x2 * sin, x1 * sin + x2 * cos], axis=-1)
    rd = HEAD_DIM // 2
    return jnp.concatenate([rotate(x[..., :rd], row), rotate(x[..., rd:], col)], axis=-1).astype(x.dtype)


def neighbourhood_attention(q, k, v, k_ctx, v_ctx, rpb):
    f32 = jnp.float32
    B, T = q.shape[0], q.shape[1]
    rows = T // GRID_W
    kh = min(NA_ROWS, rows)
    band = kh * GRID_W
    scale = HEAD_DIM ** -0.5
    t = jnp.arange(T)
    q_rot = axial_rope(q, t // GRID_W, t % GRID_W).transpose(0, 2, 1, 3)
    k_rot = axial_rope(k, t // GRID_W, t % GRID_W).transpose(0, 2, 1, 3)
    q_pl = q.transpose(0, 2, 1, 3)
    v_l = v.transpose(0, 2, 1, 3)
    kc = k_ctx.transpose(0, 2, 1, 3)
    vc = v_ctx.transpose(0, 2, 1, 3)
    key_col = jnp.arange(band) % GRID_W
    q_col = jnp.arange(GRID_W)
    col_start = jnp.clip(q_col - NA_COLS // 2, 0, GRID_W - NA_COLS)
    in_win = (key_col[None, :] >= col_start[:, None]) & (key_col[None, :] < col_start[:, None] + NA_COLS)
    dc = jnp.clip(key_col[None, :] - q_col[:, None] + NA_COLS - 1, 0, 2 * NA_COLS - 2)

    def row_block(i):
        row_start = jnp.clip(i - kh // 2, 0, rows - kh)
        qi = lax.dynamic_slice_in_dim(q_rot, i * GRID_W, GRID_W, axis=2)
        qpi = lax.dynamic_slice_in_dim(q_pl, i * GRID_W, GRID_W, axis=2)
        kb = lax.dynamic_slice_in_dim(k_rot, row_start * GRID_W, band, axis=2)
        vb = lax.dynamic_slice_in_dim(v_l, row_start * GRID_W, band, axis=2)
        dr = jnp.broadcast_to(row_start + jnp.arange(band) // GRID_W - i + NA_ROWS - 1, (GRID_W, band))
        bias = rpb[:, dr, dc].astype(f32)
        s_lat = jnp.einsum('bhqd,bhkd->bhqk', qi, kb).astype(f32) * scale + bias
        s_lat = jnp.where(in_win, s_lat, NEG_INF)
        s_ctx = jnp.einsum('bhqd,bhkd->bhqk', qpi, kc).astype(f32) * scale
        p = jax.nn.softmax(jnp.concatenate([s_lat, s_ctx], axis=-1), axis=-1).astype(v.dtype)
        return (jnp.einsum('bhqk,bhkd->bhqd', p[..., :band], vb)
                + jnp.einsum('bhqk,bhkd->bhqd', p[..., band:], vc))

    out = lax.map(row_block, jnp.arange(rows))
    return out.transpose(1, 0, 3, 2, 4).reshape(B, T, MIX_W)


def context_attention(q, k, v):
    s = jnp.einsum('blhd,bmhd->bhlm', q, k).astype(jnp.float32) * HEAD_DIM ** -0.5
    p = jax.nn.softmax(s, axis=-1).astype(v.dtype)
    out = jnp.einsum('bhlm,bmhd->blhd', p, v)
    return out.reshape(out.shape[0], out.shape[1], MIX_W)


def merge_branches(gate_u, branches, w_up, w_o):
    gates = jax.nn.sigmoid(gate_u.reshape(gate_u.shape[:-1] + (N_BRANCH, D_MODEL)))
    proj = jnp.einsum('btnm,nmd->btnd', jnp.stack(branches, axis=-2), w_up)
    return jnp.sum(gates * proj, axis=-2) @ w_o


def swiglu(h, w_in, w_out):
    a, b = jnp.split(h @ w_in, 2, axis=-1)
    return (jax.nn.silu(a) * b) @ w_out


def token_mixing(hx, hc, w_in, conv_w, rwkv_mu, rwkv_w0, rwkv_w2, rwkv_a0, rwkv_a2, rwkv_kk, rwkv_ka,
                 rwkv_rk, rwkv_g2, lnx_g, lnx_b, na_rpb, w_up, w_o, with_ctx_out):
    conv_x, rz_x, lg_x, att_x, gate_x = jnp.split(hx @ w_in, IN_SPLITS, axis=-1)
    conv_c, rz_c, lg_c, att_c, gate_c = jnp.split(hc @ w_in, IN_SPLITS, axis=-1)
    a_x = short_conv_mixer(conv_x, conv_w)
    B = hx.shape[0]
    state0 = jnp.zeros((2, B, N_HEADS, HEAD_DIM, HEAD_DIM), jnp.float32)
    xs_c = rwkv_scan_inputs(rz_c, rwkv_mu, rwkv_w0, rwkv_w2, rwkv_a0, rwkv_a2, rwkv_kk, rwkv_ka)
    state_c, ys_c = wkv_scan(state0, xs_c, with_ctx_out)
    xs_x = rwkv_scan_inputs(rz_x, rwkv_mu, rwkv_w0, rwkv_w2, rwkv_a0, rwkv_a2, rwkv_kk, rwkv_ka)
    _, ys_x = wkv_scan(state_c, xs_x, True)
    b_x = rwkv_readout(ys_x, xs_x, lg_x, rwkv_rk, rwkv_g2, lnx_g, lnx_b)
    q_x, k_x, v_x = [heads(t) for t in jnp.split(att_x, 3, axis=-1)]
    q_c, k_c, v_c = [heads(t) for t in jnp.split(att_c, 3, axis=-1)]
    c_x = neighbourhood_attention(q_x, k_x, v_x, k_c, v_c, na_rpb)
    y_x = merge_branches(gate_x, (a_x, b_x, c_x), w_up, w_o)
    if not with_ctx_out:
        return y_x, None
    a_c = short_conv_mixer(conv_c, conv_w)
    b_c = rwkv_readout(ys_c, xs_c, lg_c, rwkv_rk, rwkv_g2, lnx_g, lnx_b)
    c_c = context_attention(q_c, k_c, v_c)
    y_c = merge_branches(gate_c, (a_c, b_c, c_c), w_up, w_o)
    return y_x, y_c


def setup_inputs(seed: int = 0) -> dict:
    key = jax.random.key(seed)
    ks = jax.random.split(key, 26)
    f32 = jnp.float32
    def nrm(k, shape, s):
        return s * jax.random.normal(k, shape, f32)
    return {
        'x': nrm(ks[0], (BATCH, SEQ, D_MODEL), 1.0),
        'c': nrm(ks[1], (BATCH, D_MODEL), 1.0),
        'ctx': nrm(ks[2], (BATCH, CTX_LEN, D_MODEL), 1.0),
        'c_ctx': nrm(ks[3], (D_MODEL,), 1.0),
        'w_ada': nrm(ks[4], (DEPTH, D_MODEL, 6 * D_MODEL), D_MODEL ** -0.5),
        'b_ada': nrm(ks[5], (DEPTH, 6 * D_MODEL), 0.01),
        'norm_g': 1.0 + nrm(ks[6], (DEPTH, 4, D_MODEL), 0.05),
        'w_in': nrm(ks[7], (DEPTH, D_MODEL, D_IN), D_MODEL ** -0.5),
        'conv_w': nrm(ks[8], (DEPTH, CONV_WIDTH, MIX_W), CONV_WIDTH ** -0.5),
        'rwkv_mu': jax.random.uniform(ks[9], (DEPTH, 2, C_RWKV), f32, 0.0, 1.0),
        'rwkv_w0': jax.random.uniform(ks[10], (DEPTH, 2, MIX_W), f32, -6.0, 0.0),
        'rwkv_w2': nrm(ks[11], (DEPTH, 2, D_DECAY_LORA, MIX_W), 0.1 * D_DECAY_LORA ** -0.5),
        'rwkv_a0': nrm(ks[12], (DEPTH, 2, MIX_W), 0.1),
        'rwkv_a2': nrm(ks[13], (DEPTH, 2, D_AAA_LORA, MIX_W), 0.5 * D_AAA_LORA ** -0.5),
        'rwkv_kk': 0.85 + nrm(ks[14], (DEPTH, MIX_W), 0.05),
        'rwkv_ka': 1.0 + nrm(ks[15], (DEPTH, MIX_W), 0.05),
        'rwkv_rk': nrm(ks[16], (DEPTH, N_HEADS, HEAD_DIM), 0.1),
        'rwkv_g2': nrm(ks[17], (DEPTH, D_GATE_LORA, MIX_W), D_GATE_LORA ** -0.5),
        'lnx_g': 1.0 + nrm(ks[18], (DEPTH, MIX_W), 0.05),
        'lnx_b': nrm(ks[19], (DEPTH, MIX_W), 0.01),
        'na_rpb': nrm(ks[20], (DEPTH, N_HEADS, 2 * NA_ROWS - 1, 2 * NA_COLS - 1), 0.1),
        'w_up': nrm(ks[21], (DEPTH, N_BRANCH, MIX_W, D_MODEL), MIX_W ** -0.5),
        'w_o': nrm(ks[22], (DEPTH, D_MODEL, D_MODEL), D_MODEL ** -0.5),
        'w_ffn_in': nrm(ks[23], (DEPTH, D_MODEL, 2 * D_FF), D_MODEL ** -0.5),
        'w_ffn_out': nrm(ks[24], (DEPTH, D_FF, D_MODEL), D_FF ** -0.5),
    }


def reference(x, c, ctx, c_ctx, w_ada, b_ada, norm_g, w_in, conv_w, rwkv_mu, rwkv_w0, rwkv_w2, rwkv_a0,
              rwkv_a2, rwkv_kk, rwkv_ka, rwkv_rk, rwkv_g2, lnx_g, lnx_b, na_rpb, w_up, w_o, w_ffn_in, w_ffn_out):
    for l in range(DEPTH):
        with_ctx_out = l < DEPTH - 1
        mod_x = (jax.nn.silu(c) @ w_ada[l] + b_ada[l])[:, None, :]
        mod_c = jax.nn.silu(c_ctx) @ w_ada[l] + b_ada[l]
        sh1, sc1, gate1, sh2, sc2, gate2 = jnp.split(mod_x, 6, axis=-1)
        csh1, csc1, cgate1, csh2, csc2, cgate2 = jnp.split(mod_c, 6, axis=-1)
        hx = rms_norm(x, norm_g[l, 0]) * (1.0 + sc1) + sh1
        hc = rms_norm(ctx, norm_g[l, 0]) * (1.0 + csc1) + csh1
        y_x, y_c = token_mixing(hx, hc, w_in[l], conv_w[l], rwkv_mu[l], rwkv_w0[l], rwkv_w2[l], rwkv_a0[l],
                                rwkv_a2[l], rwkv_kk[l], rwkv_ka[l], rwkv_rk[l], rwkv_g2[l], lnx_g[l], lnx_b[l],
                                na_rpb[l], w_up[l], w_o[l], with_ctx_out)
        x = x + gate1 * rms_norm(y_x, norm_g[l, 1])
        hx = rms_norm(x, norm_g[l, 2]) * (1.0 + sc2) + sh2
        x = x + gate2 * rms_norm(swiglu(hx, w_ffn_in[l], w_ffn_out[l]), norm_g[l, 3])
        if with_ctx_out:
            ctx = ctx + cgate1 * rms_norm(y_c, norm_g[l, 1])
            hc = rms_norm(ctx, norm_g[l, 2]) * (1.0 + csc2) + csh2
            ctx = ctx + cgate2 * rms_norm(swiglu(hc, w_ffn_in[l], w_ffn_out[l]), norm_g[l, 3])
    return x
```

```cpp
#include <hip/hip_runtime.h>
#include <hip/hip_cooperative_groups.h>
#include <cstdio>
namespace cg = cooperative_groups;

#ifndef MULTI_LAUNCH
#define MULTI_LAUNCH 0
#endif

typedef unsigned short bf16_t;
typedef short bf16x8 __attribute__((ext_vector_type(8)));
typedef float f32x4 __attribute__((ext_vector_type(4)));

constexpr int NB = 8, SEQ = 8192, DM = 1024, CTXL = 256;
constexpr int TL = NB * SEQ, TC = NB * CTXL, TT = TL + TC;
constexpr int DIN = 7936, DFF = 2816, NPROJ = 4864, MIXW = 512;
constexpr int NLAYER = 2;

constexpr size_t SZ_BTIN = (size_t)DIN * 1024 * 2, SZ_BTUP = (size_t)3072 * 512 * 2, SZ_BTO3 = (size_t)1024 * 3072 * 2,
                 SZ_BTF1 = (size_t)5632 * 1024 * 2, SZ_BTF2 = (size_t)1024 * 2816 * 2, SZ_BTG2 = (size_t)512 * 256 * 2;
constexpr size_t OFF_BTIN = 0, OFF_BTUP = OFF_BTIN + SZ_BTIN, OFF_BTO3 = OFF_BTUP + SZ_BTUP, OFF_BTF1 = OFF_BTO3 + SZ_BTO3,
                 OFF_BTF2 = OFF_BTF1 + SZ_BTF1, OFF_BTG2 = OFF_BTF2 + SZ_BTF2, OFF_MISC = OFF_BTG2 + SZ_BTG2;
constexpr size_t OFF_MOD = OFF_MISC;
constexpr size_t OFF_ROPE = OFF_MOD + (size_t)2 * 9 * 6144 * 4;
constexpr size_t OFF_CTXRES = OFF_MISC + (1u << 20);
constexpr size_t OFF_HX = OFF_CTXRES + (size_t)TC * 1024 * 4;
constexpr size_t SZ_HX = (size_t)TT * 1024 * 2;
constexpr size_t SZ_SEG = (size_t)TT * 1536 * 2;
constexpr size_t OFF_SCONV = OFF_HX + SZ_HX, OFF_SATTN = OFF_SCONV + SZ_SEG, OFF_SRKV = OFF_SATTN + SZ_SEG, OFF_SLORA = OFF_SRKV + SZ_SEG;
constexpr size_t OFF_BR = OFF_SLORA + (size_t)TT * 256 * 2;
constexpr size_t SZ_BR1 = (size_t)TT * 512 * 2;
constexpr size_t WS_END = OFF_BR + 3 * SZ_BR1;
constexpr size_t OFF_BON = OFF_SCONV;
constexpr size_t OFF_VT = OFF_SCONV + 2 * SZ_BR1;
constexpr size_t OFF_VTC = OFF_VT + (size_t)TL * 512 * 2;
constexpr size_t OFF_Y = OFF_HX;
constexpr size_t OFF_G = OFF_SCONV;
constexpr size_t OFF_H = OFF_SCONV;
constexpr size_t OFF_HXB = OFF_SRKV;

constexpr int LDS_BYTES = 144 * 1024;

struct Params {
    const float* in[25];
    float* out;
    unsigned char* ws;
    int ph_lo, ph_hi;
};
enum { I_X = 0, I_C, I_CTX, I_CCTX, I_WADA, I_BADA, I_NORMG, I_WIN, I_CONVW, I_MU, I_W0, I_W2, I_A0, I_A2, I_KK, I_KA, I_RK, I_G2, I_LNXG, I_LNXB, I_RPB, I_WUP, I_WO, I_WF1, I_WF2 };

__device__ __forceinline__ float bf2f(unsigned v16) { return __uint_as_float(v16 << 16); }
__device__ __forceinline__ float bflo(unsigned u) { return __uint_as_float(u << 16); }
__device__ __forceinline__ float bfhi(unsigned u) { return __uint_as_float(u & 0xffff0000u); }
__device__ __forceinline__ unsigned cvtpk(float lo, float hi) { unsigned r; asm volatile("v_cvt_pk_bf16_f32 %0, %1, %2" : "=v"(r) : "v"(lo), "v"(hi)); return r; }
__device__ __forceinline__ bf16_t f2bf(float f) { return (bf16_t)(cvtpk(f, 0.f) & 0xffffu); }
template <int CTRL> __device__ __forceinline__ float dpp(float x) { return __builtin_bit_cast(float, __builtin_amdgcn_mov_dpp(__builtin_bit_cast(int, x), CTRL, 0xf, 0xf, true)); }
constexpr int XOR1 = 0xB1, XOR2 = 0x4E, XOR7 = 0x141, XOR8 = 0x128;
__device__ __forceinline__ float sum8(float x) { x += dpp<XOR1>(x); x += dpp<XOR2>(x); x += dpp<XOR7>(x); return x; }
__device__ __forceinline__ float sum16(float x) { x = sum8(x); x += dpp<XOR8>(x); return x; }
__device__ __forceinline__ float xrow16_max(float x) {
    auto s = __builtin_amdgcn_permlane16_swap(__float_as_uint(x), __float_as_uint(x), false, false);
    x = fmaxf(__uint_as_float(s[0]), __uint_as_float(s[1]));
    auto t = __builtin_amdgcn_permlane32_swap(__float_as_uint(x), __float_as_uint(x), false, false);
    return fmaxf(__uint_as_float(t[0]), __uint_as_float(t[1]));
}
__device__ __forceinline__ float xrow16_sum(float x) {
    auto s = __builtin_amdgcn_permlane16_swap(__float_as_uint(x), __float_as_uint(x), false, false);
    x = __uint_as_float(s[0]) + __uint_as_float(s[1]);
    auto t = __builtin_amdgcn_permlane32_swap(__float_as_uint(x), __float_as_uint(x), false, false);
    return __uint_as_float(t[0]) + __uint_as_float(t[1]);
}
__device__ __forceinline__ float wave_sum(float x) { return xrow16_sum(sum16(x)); }
template <class T> __device__ __forceinline__ T* lnd(T* q) { asm volatile("" : "+s"(q)); return q; }
__device__ __forceinline__ int my_tid() { int t = threadIdx.x; asm volatile("" : "+v"(t)); return t; }
__device__ __forceinline__ int my_bid() { int t = blockIdx.x; asm volatile("" : "+s"(t)); return t; }
__device__ __forceinline__ int my_nb() { int t = gridDim.x; asm volatile("" : "+s"(t)); return t; }
__device__ __forceinline__ float sigmoidf_(float x) { return 1.f / (1.f + __expf(-x)); }
__device__ __forceinline__ float tanh_fast(float x) { return 1.f - 2.f / (1.f + __expf(2.f * x)); }

namespace pg8 {
#define PG8_LAS __attribute__((address_space(3)))
constexpr int BM = 256, BK = 64, HALF = 128, HTB = HALF * BK * 2, STAGE_BYTES = 8 * HTB, NXCD = 8, WGM = 8;
__host__ __device__ __forceinline__ int lds_byte(int r, int c) { const int st = (r >> 4) * 2 + (c >> 5), rr = r & 15, cc = c & 31, ob = rr * 64 + cc * 2; return st * 1024 + (ob ^ (((ob >> 9) & 1) << 5)); }
__host__ __device__ __forceinline__ void stage_rc(int b, int& R, int& C) { const int st = b / 1024, sb = b % 1024, swz = sb ^ (((sb >> 9) & 1) << 5); R = (st >> 1) * 16 + swz / 64; C = (st & 1) * 32 + (swz % 64) / 2; }
struct Unit { int pm, pn; };
struct Gemm { const bf16_t* A; const bf16_t* Bt; int M, N, K, lda; int a_div; size_t a_bstride; };
struct StaticOrder {
    int nM, nN, nwg, G, c;
    __host__ __device__ void init(int M, int N, int G_, int c_) { nM = M / BM; nN = N / BM; nwg = nM * nN; G = G_; c = c_; }
    __host__ __device__ bool next(int i, Unit& u) const {
        const long L = (long)i * G + c; if (L >= nwg) return false;
        int wgid = (int)L; { const int q = nwg / NXCD, r = nwg % NXCD, xcd = wgid % NXCD, off = wgid / NXCD; wgid = (xcd < r ? xcd * (q + 1) : r * (q + 1) + (xcd - r) * q) + off; }
        const int nig = WGM * nN, gid = wgid / nig, fm = gid * WGM, gsz = (nM - fm) < WGM ? (nM - fm) : WGM;
        u.pm = fm + ((wgid % nig) % gsz); u.pn = (wgid % nig) / gsz; return true;
    }
};

template <class Epi>
__device__ __forceinline__ void gemm_phase(PG8_LAS unsigned char* lds, const Gemm g, const StaticOrder& S, const Epi& E) {
    const int tid = my_tid(), wid = __builtin_amdgcn_readfirstlane(tid >> 6), lane = tid & 63, wr = wid >> 2, wc = wid & 3, fr = lane & 15, fq = lane >> 4;
    const int K = g.K, nt = K / BK, lda = g.lda;
    unsigned voffA[2], voffB[2];
#pragma unroll
    for (int i = 0; i < 2; ++i) { int R, C; stage_rc(tid * 16 + i * 8192, R, C);
        voffA[i] = (unsigned)(R * lda + C) * 2u; voffB[i] = (unsigned)(R * K + C) * 2u; }
    const size_t kstep = (size_t)(BK * 2);
    const size_t hsA = (size_t)HALF * lda * 2, hsB = (size_t)HALF * K * 2;
    const size_t tsA = 2 * hsA, tsB = 2 * hsB;
    const unsigned ldsw = (unsigned)wid * 1024u;
    const int aoff = lds_byte(wr * 64 + fr, fq * 8), boff = lds_byte(wc * 32 + fr, fq * 8);
#define PG8_SA(b, h) (((b) * 2 + (h)) * HTB)
#define PG8_SB(b, h) ((4 + (b) * 2 + (h)) * HTB)
#define PG8_STAGE(bufoff, gbase, voff) do { _Pragma("unroll") for (int _i = 0; _i < 2; ++_i) \
        __builtin_amdgcn_global_load_lds((const unsigned*)((const char*)(gbase) + (voff)[_i]), (PG8_LAS unsigned*)(lds + (bufoff) + ldsw + _i * 8192), 16, 0, 0); } while (0)
#define PG8_LDA(dst, b, h) do { _Pragma("unroll") for (int m = 0; m < 4; ++m) _Pragma("unroll") for (int k = 0; k < 2; ++k) dst[m][k] = *(const PG8_LAS bf16x8*)(lds + PG8_SA(b, h) + aoff + m * 2048 + k * 1024); } while (0)
#define PG8_LDB(dst, b, h) do { _Pragma("unroll") for (int n = 0; n < 2; ++n) _Pragma("unroll") for (int k = 0; k < 2; ++k) dst[n][k] = *(const PG8_LAS bf16x8*)(lds + PG8_SB(b, h) + boff + n * 2048 + k * 1024); } while (0)
#define PG8_MMA(ai, bj, At, Bt) do { __builtin_amdgcn_s_setprio(1); _Pragma("unroll") for (int m = 0; m < 4; ++m) _Pragma("unroll") for (int n = 0; n < 2; ++n) _Pragma("unroll") for (int k = 0; k < 2; ++k) \
        acc[ai][bj][m][n] = __builtin_amdgcn_mfma_f32_16x16x32_bf16(Bt[n][k], At[m][k], acc[ai][bj][m][n], 0, 0, 0); __builtin_amdgcn_s_setprio(0); } while (0)
#define PG8_WAIT_V(n) asm volatile("s_waitcnt vmcnt(" #n ")" ::: "memory")
#define PG8_WAIT_L(n) asm volatile("s_waitcnt lgkmcnt(" #n ")" ::: "memory")
#define PG8_BAR __builtin_amdgcn_s_barrier()
#define PG8_SCHED __builtin_amdgcn_sched_barrier(0)
#define PG8_APTR(u) ((const char*)g.A + (size_t)((u).pn / g.a_div) * g.a_bstride + (size_t)(u).pm * tsA)
    Unit cur, nxt; int ui = 0;
    if (!S.next(0, cur)) return;
    f32x4 acc[2][2][4][2];
#pragma unroll
    for (int a = 0; a < 2; ++a)
#pragma unroll
        for (int b = 0; b < 2; ++b)
#pragma unroll
            for (int m = 0; m < 4; ++m)
#pragma unroll
                for (int n = 0; n < 2; ++n) acc[a][b][m][n] = (f32x4){0.f, 0.f, 0.f, 0.f};
    bf16x8 At[4][2], B0[2][2], B1[2][2];
    const char* cA = PG8_APTR(cur); const char* cB = (const char*)g.Bt + (size_t)cur.pn * tsB;
    PG8_STAGE(PG8_SB(0, 0), cB, voffB); PG8_STAGE(PG8_SA(0, 0), cA, voffA); PG8_STAGE(PG8_SB(0, 1), cB + hsB, voffB); PG8_STAGE(PG8_SA(0, 1), cA + hsA, voffA);
    if (wr == 1) PG8_BAR;
    PG8_WAIT_V(4); PG8_BAR;
    PG8_STAGE(PG8_SB(1, 0), cB + kstep, voffB); PG8_STAGE(PG8_SA(1, 0), cA + kstep, voffA); PG8_STAGE(PG8_SB(1, 1), cB + hsB + kstep, voffB);
    PG8_WAIT_V(6); PG8_BAR;
    for (;;) {
        const bool has_next = S.next(ui + 1, nxt);
        const char* nA = has_next ? PG8_APTR(nxt) : cA; const char* nB = has_next ? (const char*)g.Bt + (size_t)nxt.pn * tsB : cB;
        for (int t = 0; t < nt; t += 2) {
            const bool last = (t == nt - 2);
            const char* a1 = cA + (size_t)(t + 1) * kstep;
            const char* a2 = last ? nA : cA + (size_t)(t + 2) * kstep; const char* b2 = last ? nB : cB + (size_t)(t + 2) * kstep;
            const char* a3 = a2 + kstep; const char* b3 = b2 + kstep;
            PG8_LDB(B0, 0, 0); PG8_SCHED; PG8_LDA(At, 0, 0); PG8_STAGE(PG8_SA(1, 1), a1 + hsA, voffA);
            PG8_WAIT_L(8); PG8_BAR; PG8_WAIT_L(0); PG8_MMA(0, 0, At, B0); PG8_BAR; PG8_SCHED;
            PG8_LDB(B1, 0, 1); PG8_STAGE(PG8_SB(0, 0), b2, voffB);
            PG8_BAR; PG8_WAIT_L(0); PG8_MMA(0, 1, At, B1); PG8_BAR;
            PG8_LDA(At, 0, 1); PG8_STAGE(PG8_SA(0, 0), a2, voffA);
            PG8_BAR; PG8_WAIT_L(0); PG8_MMA(1, 0, At, B0); PG8_BAR; PG8_SCHED;
            PG8_STAGE(PG8_SB(0, 1), b2 + hsB, voffB);
            PG8_WAIT_V(6); PG8_BAR; PG8_MMA(1, 1, At, B1); PG8_BAR;
            PG8_LDB(B0, 1, 0); PG8_SCHED; PG8_LDA(At, 1, 0); PG8_STAGE(PG8_SA(0, 1), a2 + hsA, voffA);
            PG8_WAIT_L(8); PG8_BAR; PG8_WAIT_L(0); PG8_MMA(0, 0, At, B0); PG8_BAR; PG8_SCHED;
            PG8_LDB(B1, 1, 1); PG8_STAGE(PG8_SB(1, 0), b3, voffB);
            PG8_BAR; PG8_WAIT_L(0); PG8_MMA(0, 1, At, B1); PG8_BAR;
            PG8_LDA(At, 1, 1); PG8_STAGE(PG8_SA(1, 0), a3, voffA);
            PG8_BAR; PG8_WAIT_L(0); PG8_MMA(1, 0, At, B0); PG8_BAR; PG8_SCHED;
            PG8_STAGE(PG8_SB(1, 1), b3 + hsB, voffB);
            PG8_WAIT_V(6); PG8_BAR; PG8_MMA(1, 1, At, B1); PG8_BAR;
        }
        E(acc, cur, wr, wc, fr, fq);
        if (!has_next) break;
#pragma unroll
        for (int a = 0; a < 2; ++a)
#pragma unroll
            for (int b = 0; b < 2; ++b)
#pragma unroll
                for (int m = 0; m < 4; ++m)
#pragma unroll
                    for (int n = 0; n < 2; ++n) acc[a][b][m][n] = (f32x4){0.f, 0.f, 0.f, 0.f};
        cur = nxt; cA = nA; cB = nB; ++ui;
    }
    PG8_WAIT_V(0);
    if (wr == 0) PG8_BAR;
    PG8_BAR;
#undef PG8_SA
#undef PG8_SB
#undef PG8_STAGE
#undef PG8_LDA
#undef PG8_LDB
#undef PG8_MMA
#undef PG8_WAIT_V
#undef PG8_WAIT_L
#undef PG8_BAR
#undef PG8_SCHED
#undef PG8_APTR
}

template <class F> struct EpiT {
    F f;
    __device__ __forceinline__ void operator()(const f32x4 (&acc)[2][2][4][2], const Unit& u, int wr, int wc, int fr, int fq) const {
        const int row0 = u.pm * BM + wr * 64 + fr;
#pragma unroll
        for (int ai = 0; ai < 2; ++ai)
#pragma unroll
            for (int m = 0; m < 4; ++m) {
                const int row = row0 + ai * HALF + m * 16;
#pragma unroll
                for (int bj = 0; bj < 2; ++bj) f(row, u.pn, bj * HALF + wc * 32 + fq * 4, acc[ai][bj][m][0], acc[ai][bj][m][1]);
            }
    }
};
}


__device__ __forceinline__ void st4bf(bf16_t* p, f32x4 v) { *(uint2*)p = make_uint2(cvtpk(v[0], v[1]), cvtpk(v[2], v[3])); }

struct FProj {
    unsigned char* ws;
    __device__ __forceinline__ void operator()(int row, int pn, int cw, f32x4 v0, f32x4 v1) const {
        bf16_t* p;
        if (pn < 18) { const int seg = pn / 6; p = (bf16_t*)(ws + OFF_SCONV + (size_t)seg * SZ_SEG) + (size_t)row * 1536 + (pn - seg * 6) * 256 + cw; }
        else p = (bf16_t*)(ws + OFF_SLORA) + (size_t)row * 256 + cw;
        st4bf(p, v0); st4bf(p + 16, v1);
    }
};
struct FPlain { bf16_t* O; int ld;
    __device__ __forceinline__ void operator()(int row, int pn, int cw, f32x4 v0, f32x4 v1) const {
        bf16_t* p = O + (size_t)row * ld + pn * 256 + cw; st4bf(p, v0); st4bf(p + 16, v1); } };
struct FSig { bf16_t* O; int ld;
    __device__ __forceinline__ void operator()(int row, int pn, int cw, f32x4 v0, f32x4 v1) const {
        bf16_t* p = O + (size_t)row * ld + pn * 256 + cw;
#pragma unroll
        for (int j = 0; j < 4; ++j) { v0[j] = sigmoidf_(v0[j]); v1[j] = sigmoidf_(v1[j]); }
        st4bf(p, v0); st4bf(p + 16, v1); } };
struct FMulG { bf16_t* G; int ld;
    __device__ __forceinline__ void operator()(int row, int pn, int cw, f32x4 v0, f32x4 v1) const {
        bf16_t* p = G + (size_t)row * ld + pn * 256 + cw;
        const uint2 g0 = *(const uint2*)p, g1 = *(const uint2*)(p + 16);
        v0[0] *= bflo(g0.x); v0[1] *= bfhi(g0.x); v0[2] *= bflo(g0.y); v0[3] *= bfhi(g0.y);
        v1[0] *= bflo(g1.x); v1[1] *= bfhi(g1.x); v1[2] *= bflo(g1.y); v1[3] *= bfhi(g1.y);
        st4bf(p, v0); st4bf(p + 16, v1); } };
struct FSwiglu { bf16_t* H;
    __device__ __forceinline__ void operator()(int row, int pn, int cw, f32x4 a, f32x4 b) const {
        const int hc = pn * 128 + (cw >> 5) * 16 + (cw & 15);
        f32x4 o;
#pragma unroll
        for (int j = 0; j < 4; ++j) o[j] = a[j] * sigmoidf_(a[j]) * b[j];
        st4bf(H + (size_t)row * DFF + hc, o); } };

template <class F>
__device__ __forceinline__ void run_gemm(unsigned char* smem, const bf16_t* A, int lda, const bf16_t* Bt, int N, int K, int a_div, size_t a_bstride, const F& f, int G, int c) {
    pg8::Gemm g; g.A = A; g.Bt = Bt; g.M = TT; g.N = N; g.K = K; g.lda = lda; g.a_div = a_div; g.a_bstride = a_bstride;
    pg8::StaticOrder S; S.init(TT, N, G, c);
    pg8::EpiT<F> E{f};
    pg8::gemm_phase(( PG8_LAS unsigned char*)smem, g, S, E);
}

__device__ __forceinline__ int mapcol(int mode, int n) {
    if (mode == 1) return n < 1536 ? n : (n < 3072 ? n + 1792 : (n < 4864 ? n - 1536 : n));
    if (mode == 2) { const int g = n >> 5, w = n & 31; return w < 16 ? 16 * g + w : DFF + 16 * g + (w - 16); }
    return n;
}
__device__ void xpose(const float* __restrict__ src, int src_ld, int K, int N, bf16_t* __restrict__ dst, int dst_ld, int dst_koff, int mode, float* tile, int rot) {
    const int ntk = K / 64, ntn = N / 64, tid = my_tid();
    const int bid = (int)((my_bid() + (unsigned)rot) % my_nb());
    for (int t = bid; t < ntk * ntn; t += my_nb()) {
        const int tk = t % ntk, tn = t / ntk;
#pragma unroll
        for (int p = 0; p < 8; ++p) { const int k = p * 8 + (tid >> 6), n = tid & 63;
            tile[k * 65 + n] = src[(size_t)(tk * 64 + k) * src_ld + mapcol(mode, tn * 64 + n)]; }
        __syncthreads();
#pragma unroll
        for (int p = 0; p < 8; ++p) { const int n = p * 8 + (tid >> 6), k = tid & 63;
            dst[(size_t)(tn * 64 + n) * dst_ld + dst_koff + tk * 64 + k] = f2bf(tile[k * 65 + n]); }
        __syncthreads();
    }
}
__device__ void convert_weights(const Params& p, int l, float* tile) {
    unsigned char* ws = lnd(p.ws);
    xpose(lnd(p.in[I_WIN]) + (size_t)l * 1024 * DIN, DIN, 1024, DIN, (bf16_t*)(ws + OFF_BTIN), 1024, 0, 1, tile, 0);
    for (int b = 0; b < 3; ++b) xpose(lnd(p.in[I_WUP]) + ((size_t)l * 3 + b) * 512 * 1024, 1024, 512, 1024, (bf16_t*)(ws + OFF_BTUP) + (size_t)b * 1024 * 512, 512, 0, 0, tile, 64 + b * 64);
    for (int b = 0; b < 3; ++b) xpose(lnd(p.in[I_WO]) + (size_t)l * 1024 * 1024, 1024, 1024, 1024, (bf16_t*)(ws + OFF_BTO3), 3072, b * 1024, 0, tile, 0);
    xpose(lnd(p.in[I_WF1]) + (size_t)l * 1024 * 2 * DFF, 2 * DFF, 1024, 2 * DFF, (bf16_t*)(ws + OFF_BTF1), 1024, 0, 2, tile, 0);
    xpose(lnd(p.in[I_WF2]) + (size_t)l * DFF * 1024, 1024, DFF, 1024, (bf16_t*)(ws + OFF_BTF2), DFF, 0, 0, tile, 128);
    xpose(lnd(p.in[I_G2]) + (size_t)l * 128 * 512, 512, 128, 512, (bf16_t*)(ws + OFF_BTG2), 256, 128, 0, tile, 200);
    bf16_t* g2 = (bf16_t*)(ws + OFF_BTG2);
    for (int i = my_bid() * 512 + my_tid(); i < 512 * 128; i += my_nb() * 512) g2[(i >> 7) * 256 + (i & 127)] = 0;
}

__device__ void prologue_mods(const Params& p, float* lds) {
    float* sc = lds;
    float* red = lds + 9 * 1024;
    const int tid = my_tid();
    for (int e = tid; e < 9 * 1024; e += 512) { const int v = e >> 10, k = e & 1023; const float x = v < 8 ? lnd(p.in[I_C])[v * 1024 + k] : lnd(p.in[I_CCTX])[k]; sc[e] = x * sigmoidf_(x); }
    __syncthreads();
    const int kg = tid >> 4, cl = tid & 15;
    float* mod = (float*)(lnd(p.ws) + OFF_MOD);
    for (int cgp = my_bid(); cgp < 2 * 384; cgp += my_nb()) {
        const int l = cgp / 384, col = (cgp % 384) * 16 + cl;
        float acc[9];
#pragma unroll
        for (int v = 0; v < 9; ++v) acc[v] = 0.f;
        const float* w = lnd(p.in[I_WADA]) + (size_t)l * 1024 * 6144 + col;
        for (int k = kg * 32; k < kg * 32 + 32; ++k) { const float wv = w[(size_t)k * 6144];
#pragma unroll
            for (int v = 0; v < 9; ++v) acc[v] += sc[v * 1024 + k] * wv; }
#pragma unroll
        for (int v = 0; v < 9; ++v) red[(kg * 16 + cl) * 9 + v] = acc[v];
        __syncthreads();
        if (tid < 144) { const int c2 = tid / 9, v = tid % 9; float s = 0.f;
            for (int g = 0; g < 32; ++g) s += red[(g * 16 + c2) * 9 + v];
            const int cc = (cgp % 384) * 16 + c2;
            mod[((size_t)l * 9 + v) * 6144 + cc] = s + lnd(p.in[I_BADA])[l * 6144 + cc]; }
        __syncthreads();
    }
    float* rope = (float*)(lnd(p.ws) + OFF_ROPE);
    for (int i = my_bid() * 512 + tid; i < 192 * 16; i += my_nb() * 512) {
        const int pos = i >> 4, j = i & 15; const int pp = pos < 128 ? pos : pos - 128;
        const float fr = exp2f(-(float)j * 0.83048202372f);
        const float ang = (float)pp * fr;
        rope[i] = __cosf(ang); rope[192 * 16 + i] = __sinf(ang);
    }
}

__device__ void rowwise(const Params& p, const float* xs_lat, const float* xs_ctx, float* xd_lat, float* xd_ctx,
                        const bf16_t* Y, const float* gy, const float* modY, int gate_chunk,
                        bf16_t* HXo, const float* gh, const float* modH, int sh_chunk, int sc_chunk) {
    const int tid = my_tid(); const int lane = tid & 63, gw = my_bid() * 8 + (tid >> 6), nw = my_nb() * 8;
    for (int row = gw; row < TT; row += nw) {
        const bool lat = row < TL;
        const int v = lat ? (row >> 13) : 8;
        const float* xr = lat ? xs_lat + (size_t)row * 1024 : xs_ctx + (size_t)(row - TL) * 1024;
        float4 x[4];
#pragma unroll
        for (int i = 0; i < 4; ++i) x[i] = *(const float4*)(xr + i * 256 + lane * 4);
        if (Y) {
            float y[16]; float ss = 0.f;
#pragma unroll
            for (int i = 0; i < 4; ++i) { const uint2 u = *(const uint2*)(Y + (size_t)row * 1024 + i * 256 + lane * 4);
                y[4 * i] = bflo(u.x); y[4 * i + 1] = bfhi(u.x); y[4 * i + 2] = bflo(u.y); y[4 * i + 3] = bfhi(u.y); }
#pragma unroll
            for (int i = 0; i < 16; ++i) ss += y[i] * y[i];
            ss = wave_sum(ss);
            const float rn = rsqrtf(ss * (1.f / 1024.f) + 1e-6f);
            const float* gt = modY + (size_t)v * 6144 + gate_chunk * 1024;
#pragma unroll
            for (int i = 0; i < 4; ++i) { const int c = i * 256 + lane * 4; const float4 g = *(const float4*)(gy + c), t = *(const float4*)(gt + c);
                x[i].x += t.x * (y[4 * i] * rn * g.x); x[i].y += t.y * (y[4 * i + 1] * rn * g.y); x[i].z += t.z * (y[4 * i + 2] * rn * g.z); x[i].w += t.w * (y[4 * i + 3] * rn * g.w); }
            float* xw = lat ? xd_lat + (size_t)row * 1024 : xd_ctx + (size_t)(row - TL) * 1024;
#pragma unroll
            for (int i = 0; i < 4; ++i) *(float4*)(xw + i * 256 + lane * 4) = x[i];
        }
        if (HXo) {
            float ss = 0.f;
#pragma unroll
            for (int i = 0; i < 4; ++i) ss += x[i].x * x[i].x + x[i].y * x[i].y + x[i].z * x[i].z + x[i].w * x[i].w;
            ss = wave_sum(ss);
            const float rn = rsqrtf(ss * (1.f / 1024.f) + 1e-6f);
            const float* sh = modH + (size_t)v * 6144 + sh_chunk * 1024; const float* scp = modH + (size_t)v * 6144 + sc_chunk * 1024;
#pragma unroll
            for (int i = 0; i < 4; ++i) { const int c = i * 256 + lane * 4; const float4 g = *(const float4*)(gh + c), a = *(const float4*)(scp + c), b = *(const float4*)(sh + c);
                const float o0 = x[i].x * rn * g.x * (1.f + a.x) + b.x, o1 = x[i].y * rn * g.y * (1.f + a.y) + b.y, o2 = x[i].z * rn * g.z * (1.f + a.z) + b.z, o3 = x[i].w * rn * g.w * (1.f + a.w) + b.w;
                *(uint2*)(HXo + (size_t)row * 1024 + c) = make_uint2(cvtpk(o0, o1), cvtpk(o2, o3)); }
        }
    }
}

__device__ __forceinline__ void unpack8(const uint4 u, float* f) { f[0] = bflo(u.x); f[1] = bfhi(u.x); f[2] = bflo(u.y); f[3] = bfhi(u.y); f[4] = bflo(u.z); f[5] = bfhi(u.z); f[6] = bflo(u.w); f[7] = bfhi(u.w); }
__device__ __forceinline__ uint4 pack8(const float* f) { return make_uint4(cvtpk(f[0], f[1]), cvtpk(f[2], f[3]), cvtpk(f[4], f[5]), cvtpk(f[6], f[7])); }

__device__ void phase_elem(const Params& p, int l) {
    unsigned char* ws = lnd(p.ws);
    const bf16_t* SC = (const bf16_t*)(ws + OFF_SCONV);
    bf16_t* SA = (bf16_t*)(ws + OFF_SATTN);
    bf16_t* SL = (bf16_t*)(ws + OFF_SLORA);
    bf16_t* BR0 = (bf16_t*)(ws + OFF_BR);
    bf16_t* BR2 = (bf16_t*)(ws + OFF_BR + 2 * SZ_BR1);
    const float* cw = lnd(p.in[I_CONVW]) + (size_t)l * 3 * 512;
    const float* rope = (const float*)(ws + OFF_ROPE);
    const size_t gt = (size_t)my_bid() * 512 + my_tid(), gn = (size_t)my_nb() * 512;
    for (size_t idx = gt; idx < (size_t)TT * 64; idx += gn) {
        const int row = (int)(idx >> 6), c8 = (int)(idx & 63) * 8;
        bool hp, hn;
        if (row < TL) { const int t = row & 8191; hp = t > 0; hn = t < 8191; } else { const int t = (row - TL) & 255; hp = t > 0; hn = t < 255; }
        float z[3][8];
#pragma unroll
        for (int o = 0; o < 3; ++o) {
            const bool ok = o == 1 || (o == 0 ? hp : hn);
            if (ok) { const bf16_t* r = SC + (size_t)(row + o - 1) * 1536; float c[8], h[8]; unpack8(*(const uint4*)(r + 512 + c8), c); unpack8(*(const uint4*)(r + 1024 + c8), h);
#pragma unroll
                for (int e = 0; e < 8; ++e) z[o][e] = c[e] * h[e]; }
            else {
#pragma unroll
                for (int e = 0; e < 8; ++e) z[o][e] = 0.f; }
        }
        float bg[8], o8[8]; unpack8(*(const uint4*)(SC + (size_t)row * 1536 + c8), bg);
#pragma unroll
        for (int e = 0; e < 8; ++e) o8[e] = bg[e] * (cw[c8 + e] * z[0][e] + cw[512 + c8 + e] * z[1][e] + cw[1024 + c8 + e] * z[2][e]);
        *(uint4*)(BR0 + (size_t)row * 512 + c8) = pack8(o8);
    }
    for (size_t idx = gt; idx < (size_t)TL * 64; idx += gn) {
        const int row = (int)(idx >> 6), rem = (int)(idx & 63);
        const int which = rem >> 5, head = (rem >> 2) & 7, part = (rem >> 1) & 1, sub = rem & 1;
        const int t = row & 8191; const int pos = part == 0 ? (t >> 6) : 128 + (t & 63);
        const float* cs = rope + pos * 16 + sub * 8; const float* sn = cs + 192 * 16;
        const int off = which * 512 + head * 64 + part * 32 + sub * 8;
        const bf16_t* src = SA + (size_t)row * 1536 + off;
        float x1[8], x2[8], o1[8], o2[8]; unpack8(*(const uint4*)src, x1); unpack8(*(const uint4*)(src + 16), x2);
#pragma unroll
        for (int e = 0; e < 8; ++e) { o1[e] = x1[e] * cs[e] - x2[e] * sn[e]; o2[e] = x1[e] * sn[e] + x2[e] * cs[e]; }
        bf16_t* dst = which == 0 ? BR2 + (size_t)row * 512 + head * 64 + part * 32 + sub * 8 : SA + (size_t)row * 1536 + off;
        *(uint4*)dst = pack8(o1); *(uint4*)(dst + 16) = pack8(o2);
    }
    for (size_t idx = gt; idx < (size_t)TT * 16; idx += gn) {
        const int row = (int)(idx >> 4), c8 = 128 + (int)(idx & 15) * 8;
        bf16_t* q = SL + (size_t)row * 256 + c8; float f[8]; unpack8(*(const uint4*)q, f);
#pragma unroll
        for (int e = 0; e < 8; ++e) f[e] = sigmoidf_(f[e]);
        *(uint4*)q = pack8(f);
    }
}

__device__ void phase_vt(const Params& p, float* lds) {
    unsigned char* ws = lnd(p.ws);
    const bf16_t* SA = (const bf16_t*)(ws + OFF_SATTN);
    bf16_t* VT = (bf16_t*)(ws + OFF_VT); bf16_t* VTC = (bf16_t*)(ws + OFF_VTC);
    bf16_t* tile = (bf16_t*)lds;
    const int tid = my_tid();
    const int nlat = 8 * 8 * 128, nall = nlat + 8 * 8 * 4;
    for (int it = my_bid(); it < nall; it += my_nb()) {
        int b, h, t0, rowbase, tlen; bf16_t* dst;
        if (it < nlat) { b = it >> 10; h = (it >> 7) & 7; t0 = (it & 127) * 64; rowbase = b * 8192 + t0; tlen = 8192; dst = VT + ((size_t)(b * 8 + h) * 64) * 8192 + t0; }
        else { const int j = it - nlat; b = j >> 5; h = (j >> 2) & 7; t0 = (j & 3) * 64; rowbase = TL + b * 256 + t0; tlen = 256; dst = VTC + ((size_t)(b * 8 + h) * 64) * 256 + t0; }
        { const int tk = tid >> 3, d8 = (tid & 7) * 8;
          const uint4 u = *(const uint4*)(SA + (size_t)(rowbase + tk) * 1536 + 1024 + h * 64 + d8);
          bf16_t* tp = tile + tk * 66 + d8; ((unsigned*)tp)[0] = u.x; ((unsigned*)tp)[1] = u.y; ((unsigned*)tp)[2] = u.z; ((unsigned*)tp)[3] = u.w; }
        __syncthreads();
        { const int d = tid >> 3, k8 = (tid & 7) * 8;
          unsigned o[4];
#pragma unroll
          for (int e = 0; e < 4; ++e) o[e] = (unsigned)tile[(k8 + 2 * e) * 66 + d] | ((unsigned)tile[(k8 + 2 * e + 1) * 66 + d] << 16);
          *(uint4*)(dst + (size_t)d * tlen + k8) = make_uint4(o[0], o[1], o[2], o[3]); }
        __syncthreads();
    }
}

__device__ void attn_wave(const Params& p, const float* rpb_l  , bool is_ctx, int b, int h, int i, int g) {
    unsigned char* ws = lnd(p.ws);
    const bf16_t* SA = (const bf16_t*)(ws + OFF_SATTN);
    bf16_t* BR2 = (bf16_t*)(ws + OFF_BR + 2 * SZ_BR1);
    const bf16_t* VT = (const bf16_t*)(ws + OFF_VT) + ((size_t)(b * 8 + h) * 64) * 8192;
    const bf16_t* VTC = (const bf16_t*)(ws + OFF_VTC) + ((size_t)(b * 8 + h) * 64) * 256;
    const int lane = my_tid() & 63, ql = lane & 15, g4 = lane >> 4;
    const int koff = 8 * (ql >> 2) + (ql & 3);
    int rowq, qcol = 0;
    if (is_ctx) rowq = TL + b * 256 + g * 16 + ql; else { qcol = g * 16 + ql; rowq = b * 8192 + i * 64 + qcol; }
    bf16x8 qp[2], qr[2];
    qp[0] = *(const bf16x8*)(SA + (size_t)rowq * 1536 + h * 64 + g4 * 8); qp[1] = *(const bf16x8*)(SA + (size_t)rowq * 1536 + h * 64 + 32 + g4 * 8);
    float m_run = -1e30f, l_run = 0.f;
    f32x4 O[4];
#pragma unroll
    for (int mt = 0; mt < 4; ++mt) O[mt] = (f32x4){0.f, 0.f, 0.f, 0.f};
    const f32x4 zero4 = (f32x4){0.f, 0.f, 0.f, 0.f};
    if (!is_ctx) {
        qr[0] = *(const bf16x8*)(BR2 + (size_t)rowq * 512 + h * 64 + g4 * 8); qr[1] = *(const bf16x8*)(BR2 + (size_t)rowq * 512 + h * 64 + 32 + g4 * 8);
        const int row_start = min(max(i - 4, 0), 120), c0 = min(max(16 * g - 8, 0), 32), col_start = min(max(qcol - 8, 0), 48);
        const float* rb = rpb_l + h * 465;
        for (int r = 0; r < 8; ++r) {
            const int krow = row_start + r, t0 = krow * 64 + c0;
            const bf16_t* kp0 = SA + (size_t)(b * 8192 + t0 + koff) * 1536 + 512 + h * 64 + g4 * 8; const bf16_t* kp1 = kp0 + (size_t)4 * 1536;
            const bf16x8 k00 = *(const bf16x8*)kp0, k01 = *(const bf16x8*)(kp0 + 32), k10 = *(const bf16x8*)kp1, k11 = *(const bf16x8*)(kp1 + 32);
            bf16x8 vf[4];
#pragma unroll
            for (int mt = 0; mt < 4; ++mt) vf[mt] = *(const bf16x8*)(VT + (size_t)(mt * 16 + ql) * 8192 + t0 + 8 * g4);
            f32x4 s0 = __builtin_amdgcn_mfma_f32_16x16x32_bf16(k00, qr[0], zero4, 0, 0, 0); s0 = __builtin_amdgcn_mfma_f32_16x16x32_bf16(k01, qr[1], s0, 0, 0, 0);
            f32x4 s1 = __builtin_amdgcn_mfma_f32_16x16x32_bf16(k10, qr[0], zero4, 0, 0, 0); s1 = __builtin_amdgcn_mfma_f32_16x16x32_bf16(k11, qr[1], s1, 0, 0, 0);
            const float* rbr = rb + (krow - i + 7) * 31;
            float sc[8]; float mx = -1e30f;
#pragma unroll
            for (int e = 0; e < 8; ++e) {
                const int kc = c0 + 8 * g4 + e; const int dc = min(max(kc - qcol + 15, 0), 30);
                const float raw = e < 4 ? s0[e & 3] : s1[e & 3];
                const bool inw = kc >= col_start && kc < col_start + 16;
                sc[e] = inw ? raw * 0.125f + rbr[dc] : -1e30f; mx = fmaxf(mx, sc[e]);
            }
            mx = xrow16_max(mx);
            const float m_new = fmaxf(m_run, mx), alpha = __expf(m_run - m_new); m_run = m_new;
            float ps = 0.f;
#pragma unroll
            for (int e = 0; e < 8; ++e) { sc[e] = __expf(sc[e] - m_new); ps += sc[e]; }
            l_run = l_run * alpha + ps;
            bf16x8 pf; { const unsigned u0 = cvtpk(sc[0], sc[1]), u1 = cvtpk(sc[2], sc[3]), u2 = cvtpk(sc[4], sc[5]), u3 = cvtpk(sc[6], sc[7]);
                typedef unsigned u32x4 __attribute__((ext_vector_type(4))); const u32x4 uu = {u0, u1, u2, u3}; pf = __builtin_bit_cast(bf16x8, uu); }
#pragma unroll
            for (int mt = 0; mt < 4; ++mt) { O[mt] *= alpha; O[mt] = __builtin_amdgcn_mfma_f32_16x16x32_bf16(vf[mt], pf, O[mt], 0, 0, 0); }
        }
    }
    for (int sp = 0; sp < 8; ++sp) {
        const bf16_t* kp0 = SA + (size_t)(TL + b * 256 + sp * 32 + koff) * 1536 + 512 + h * 64 + g4 * 8; const bf16_t* kp1 = kp0 + (size_t)4 * 1536;
        const bf16x8 k00 = *(const bf16x8*)kp0, k01 = *(const bf16x8*)(kp0 + 32), k10 = *(const bf16x8*)kp1, k11 = *(const bf16x8*)(kp1 + 32);
        bf16x8 vf[4];
#pragma unroll
        for (int mt = 0; mt < 4; ++mt) vf[mt] = *(const bf16x8*)(VTC + (size_t)(mt * 16 + ql) * 256 + sp * 32 + 8 * g4);
        f32x4 s0 = __builtin_amdgcn_mfma_f32_16x16x32_bf16(k00, qp[0], zero4, 0, 0, 0); s0 = __builtin_amdgcn_mfma_f32_16x16x32_bf16(k01, qp[1], s0, 0, 0, 0);
        f32x4 s1 = __builtin_amdgcn_mfma_f32_16x16x32_bf16(k10, qp[0], zero4, 0, 0, 0); s1 = __builtin_amdgcn_mfma_f32_16x16x32_bf16(k11, qp[1], s1, 0, 0, 0);
        float sc[8]; float mx = -1e30f;
#pragma unroll
        for (int e = 0; e < 8; ++e) { sc[e] = (e < 4 ? s0[e & 3] : s1[e & 3]) * 0.125f; mx = fmaxf(mx, sc[e]); }
        mx = xrow16_max(mx);
        const float m_new = fmaxf(m_run, mx), alpha = __expf(m_run - m_new); m_run = m_new;
        float ps = 0.f;
#pragma unroll
        for (int e = 0; e < 8; ++e) { sc[e] = __expf(sc[e] - m_new); ps += sc[e]; }
        l_run = l_run * alpha + ps;
        bf16x8 pf; { const unsigned u0 = cvtpk(sc[0], sc[1]), u1 = cvtpk(sc[2], sc[3]), u2 = cvtpk(sc[4], sc[5]), u3 = cvtpk(sc[6], sc[7]);
            typedef unsigned u32x4 __attribute__((ext_vector_type(4))); const u32x4 uu = {u0, u1, u2, u3}; pf = __builtin_bit_cast(bf16x8, uu); }
#pragma unroll
        for (int mt = 0; mt < 4; ++mt) { O[mt] *= alpha; O[mt] = __builtin_amdgcn_mfma_f32_16x16x32_bf16(vf[mt], pf, O[mt], 0, 0, 0); }
    }
    const float inv = 1.f / xrow16_sum(l_run);
#pragma unroll
    for (int mt = 0; mt < 4; ++mt) st4bf(BR2 + (size_t)rowq * 512 + h * 64 + mt * 16 + 4 * g4, O[mt] * inv);
}

__device__ void phase_attn(const Params& p, int l, float* lds, int ab, int nab) {
    const int tid = my_tid(), w = tid >> 6;
    const float* rpb = lnd(p.in[I_RPB]) + (size_t)l * 8 * 465;
    for (int e = tid; e < 8 * 465; e += 512) lds[e] = rpb[e];
    __syncthreads();
    const int nlat = 8 * 128 * 4, nall = nlat + (l == 0 ? 128 : 0);
    for (int u = ab; u < nall; u += nab) {
        if (u < nlat) { const int b = u >> 9, i = (u >> 2) & 127, hp = u & 3; attn_wave(p, lds, false, b, 2 * hp + (w >> 2), i, w & 3); }
        else { const int j = u - nlat; const int b = j >> 4, hp = (j >> 2) & 3, qq = j & 3; attn_wave(p, lds, true, b, 2 * hp + (w >> 2), 0, 4 * qq + (w & 3)); }
    }
    __syncthreads();
}

constexpr int CH = 32;
__device__ void scan_head(const Params& p, int l, int hd, float* lds) {
    unsigned char* ws = lnd(p.ws);
    const bf16_t* SR = (const bf16_t*)(ws + OFF_SRKV);
    const bf16_t* SL = (const bf16_t*)(ws + OFF_SLORA);
    const int tid = my_tid();
    const int d = hd >> 6, b = (hd >> 3) & 7, h = hd & 7;
    bf16_t* BON = (bf16_t*)(ws + OFF_BON) + (size_t)d * TT * 512;
    bf16_t* YO = (bf16_t*)(ws + OFF_Y) + (size_t)d * TT * 512;
    float* w2s = lds; float* a2s = w2s + 4096;
    float* cR = a2s + 4096; float* cW = cR + CH * 64; float* cK = cW + CH * 64; float* cV = cK + CH * 64; float* cA = cV + CH * 64; float* cB = cA + CH * 64;
    float* tl = cB + CH * 64; float* lam = tl + CH * 64; float* Yl = lam + CH * 64; float* hp = Yl + CH * 64;
    __syncthreads();
    {
        const float* w2 = lnd(p.in[I_W2]) + (size_t)(l * 2 + d) * 64 * 512 + h * 64; const float* a2 = lnd(p.in[I_A2]) + (size_t)(l * 2 + d) * 64 * 512 + h * 64;
        for (int e = tid; e < 4096; e += 512) { const int j = e >> 6, i = e & 63; w2s[e] = w2[j * 512 + i]; a2s[e] = a2[j * 512 + i]; }
        if (tid < 64) {
            const float* mu = lnd(p.in[I_MU]) + (size_t)(l * 2 + d) * 1664;
            hp[0 * 64 + tid] = lnd(p.in[I_W0])[(l * 2 + d) * 512 + h * 64 + tid];
            hp[1 * 64 + tid] = lnd(p.in[I_A0])[(l * 2 + d) * 512 + h * 64 + tid];
            hp[2 * 64 + tid] = lnd(p.in[I_KK])[l * 512 + h * 64 + tid];
            hp[3 * 64 + tid] = lnd(p.in[I_KA])[l * 512 + h * 64 + tid];
            hp[4 * 64 + tid] = lnd(p.in[I_RK])[(l * 8 + h) * 64 + tid];
            hp[5 * 64 + tid] = mu[h * 64 + tid];
            hp[6 * 64 + tid] = mu[512 + h * 64 + tid];
            hp[7 * 64 + tid] = mu[1024 + h * 64 + tid];
            hp[8 * 64 + tid] = mu[1536 + tid];
            hp[9 * 64 + tid] = mu[1600 + tid];
        }
    }
    __syncthreads();
    float S[8];
#pragma unroll
    for (int e = 0; e < 8; ++e) S[e] = 0.f;
    const int irow = tid >> 3, js = tid & 7;
    const int slp = tid >> 4, c4 = tid & 15;
    for (int chunk = 0; chunk < (CTXL + SEQ) / CH; ++chunk) {
        const int s = chunk * CH + slp;
        int row, nrow; bool nv;
        if (s < CTXL) { const int li = d ? (CTXL - 1 - s) : s; row = TL + b * CTXL + li; nv = d ? (li < CTXL - 1) : (li > 0); }
        else { const int t = d ? (SEQ - 1 - (s - CTXL)) : (s - CTXL); row = b * SEQ + t; nv = d ? (t < SEQ - 1) : (t > 0); }
        nrow = d ? row + 1 : row - 1;
        float rm[4], km[4], vm[4];
        {
            const uint2 z2 = make_uint2(0u, 0u);
            const uint2 lw = *(const uint2*)(SL + (size_t)row * 256 + 4 * c4), la = *(const uint2*)(SL + (size_t)row * 256 + 64 + 4 * c4);
            const uint2 lwn = nv ? *(const uint2*)(SL + (size_t)nrow * 256 + 4 * c4) : z2, lan = nv ? *(const uint2*)(SL + (size_t)nrow * 256 + 64 + 4 * c4) : z2;
            const float x[4] = {bflo(lw.x), bfhi(lw.x), bflo(lw.y), bfhi(lw.y)}, xn[4] = {bflo(lwn.x), bfhi(lwn.x), bflo(lwn.y), bfhi(lwn.y)};
            const float y[4] = {bflo(la.x), bfhi(la.x), bflo(la.y), bfhi(la.y)}, yn[4] = {bflo(lan.x), bfhi(lan.x), bflo(lan.y), bfhi(lan.y)};
#pragma unroll
            for (int e = 0; e < 4; ++e) { tl[slp * 64 + 4 * c4 + e] = tanh_fast(x[e] + hp[8 * 64 + 4 * c4 + e] * (xn[e] - x[e])); lam[slp * 64 + 4 * c4 + e] = y[e] + hp[9 * 64 + 4 * c4 + e] * (yn[e] - y[e]); }
            const bf16_t* pr = SR + (size_t)row * 1536 + h * 64 + 4 * c4; const bf16_t* pn = SR + (size_t)nrow * 1536 + h * 64 + 4 * c4;
            const uint2 r0 = *(const uint2*)pr, k0 = *(const uint2*)(pr + 512), v0 = *(const uint2*)(pr + 1024);
            const uint2 r1 = nv ? *(const uint2*)pn : z2, k1 = nv ? *(const uint2*)(pn + 512) : z2, v1 = nv ? *(const uint2*)(pn + 1024) : z2;
            const float ra[4] = {bflo(r0.x), bfhi(r0.x), bflo(r0.y), bfhi(r0.y)}, rb[4] = {bflo(r1.x), bfhi(r1.x), bflo(r1.y), bfhi(r1.y)};
            const float ka[4] = {bflo(k0.x), bfhi(k0.x), bflo(k0.y), bfhi(k0.y)}, kb[4] = {bflo(k1.x), bfhi(k1.x), bflo(k1.y), bfhi(k1.y)};
            const float va[4] = {bflo(v0.x), bfhi(v0.x), bflo(v0.y), bfhi(v0.y)}, vb[4] = {bflo(v1.x), bfhi(v1.x), bflo(v1.y), bfhi(v1.y)};
#pragma unroll
            for (int e = 0; e < 4; ++e) { const int i = 4 * c4 + e;
                rm[e] = ra[e] + hp[5 * 64 + i] * (rb[e] - ra[e]); km[e] = ka[e] + hp[6 * 64 + i] * (kb[e] - ka[e]); vm[e] = va[e] + hp[7 * 64 + i] * (vb[e] - va[e]); }
        }
        __syncthreads();
        {
            float wl[4], al[4];
#pragma unroll
            for (int e = 0; e < 4; ++e) { wl[e] = hp[0 * 64 + 4 * c4 + e]; al[e] = hp[1 * 64 + 4 * c4 + e]; }
            for (int j4 = 0; j4 < 16; ++j4) {
                const float4 tv = *(const float4*)(tl + slp * 64 + 4 * j4), lv = *(const float4*)(lam + slp * 64 + 4 * j4);
                const float tj[4] = {tv.x, tv.y, tv.z, tv.w}, lj[4] = {lv.x, lv.y, lv.z, lv.w};
#pragma unroll
                for (int jj = 0; jj < 4; ++jj) { const float4 wv = *(const float4*)(w2s + (4 * j4 + jj) * 64 + 4 * c4), av = *(const float4*)(a2s + (4 * j4 + jj) * 64 + 4 * c4);
                    wl[0] += tj[jj] * wv.x; wl[1] += tj[jj] * wv.y; wl[2] += tj[jj] * wv.z; wl[3] += tj[jj] * wv.w;
                    al[0] += lj[jj] * av.x; al[1] += lj[jj] * av.y; al[2] += lj[jj] * av.z; al[3] += lj[jj] * av.w; }
            }
            float kk[4], ss = 0.f, rk = 0.f, ag[4], kmod[4];
#pragma unroll
            for (int e = 0; e < 4; ++e) { const int i = 4 * c4 + e;
                const float x = -wl[e]; const float sp = fmaxf(x, 0.f) + __logf(1.f + __expf(-fabsf(x)));
                const float wlog = -sp - 0.5f; cW[slp * 64 + i] = __expf(-__expf(wlog));
                ag[e] = sigmoidf_(al[e]);
                kk[e] = km[e] * hp[2 * 64 + i]; ss += kk[e] * kk[e];
                kmod[e] = km[e] * (1.f + (ag[e] - 1.f) * hp[3 * 64 + i]);
                rk += rm[e] * kmod[e] * hp[4 * 64 + i]; }
            ss = sum16(ss); rk = sum16(rk);
            const float rn = rsqrtf(fmaxf(ss, 1e-24f));
            float bo[4];
#pragma unroll
            for (int e = 0; e < 4; ++e) { const int i = 4 * c4 + e; kk[e] *= rn;
                cR[slp * 64 + i] = rm[e]; cK[slp * 64 + i] = kmod[e]; cV[slp * 64 + i] = vm[e]; cA[slp * 64 + i] = -kk[e]; cB[slp * 64 + i] = kk[e] * ag[e]; bo[e] = rk * vm[e]; }
            *(uint2*)(BON + (size_t)row * 512 + h * 64 + 4 * c4) = make_uint2(cvtpk(bo[0], bo[1]), cvtpk(bo[2], bo[3]));
        }
        __syncthreads();
        for (int sl = 0; sl < CH; ++sl) {
            const float4 a0 = *(const float4*)(cA + sl * 64 + 8 * js), a1 = *(const float4*)(cA + sl * 64 + 8 * js + 4);
            const float4 w0 = *(const float4*)(cW + sl * 64 + 8 * js), w1 = *(const float4*)(cW + sl * 64 + 8 * js + 4);
            const float4 k0 = *(const float4*)(cK + sl * 64 + 8 * js), k1 = *(const float4*)(cK + sl * 64 + 8 * js + 4);
            const float4 b0 = *(const float4*)(cB + sl * 64 + 8 * js), b1 = *(const float4*)(cB + sl * 64 + 8 * js + 4);
            const float4 r0 = *(const float4*)(cR + sl * 64 + 8 * js), r1 = *(const float4*)(cR + sl * 64 + 8 * js + 4);
            const float vv = cV[sl * 64 + irow];
            float sa = S[0] * a0.x + S[1] * a0.y + S[2] * a0.z + S[3] * a0.w + S[4] * a1.x + S[5] * a1.y + S[6] * a1.z + S[7] * a1.w;
            sa = sum8(sa);
            S[0] = S[0] * w0.x + (vv * k0.x + sa * b0.x); S[1] = S[1] * w0.y + (vv * k0.y + sa * b0.y); S[2] = S[2] * w0.z + (vv * k0.z + sa * b0.z); S[3] = S[3] * w0.w + (vv * k0.w + sa * b0.w);
            S[4] = S[4] * w1.x + (vv * k1.x + sa * b1.x); S[5] = S[5] * w1.y + (vv * k1.y + sa * b1.y); S[6] = S[6] * w1.z + (vv * k1.z + sa * b1.z); S[7] = S[7] * w1.w + (vv * k1.w + sa * b1.w);
            float y = S[0] * r0.x + S[1] * r0.y + S[2] * r0.z + S[3] * r0.w + S[4] * r1.x + S[5] * r1.y + S[6] * r1.z + S[7] * r1.w;
            y = sum8(y);
            if (js == 0) Yl[sl * 64 + irow] = y;
        }
        __syncthreads();
        { const float4 yv = *(const float4*)(Yl + slp * 64 + 4 * c4);
          *(uint2*)(YO + (size_t)row * 512 + h * 64 + 4 * c4) = make_uint2(cvtpk(yv.x, yv.y), cvtpk(yv.z, yv.w)); }
    }
    __syncthreads();
}

__device__ void phase_readout(const Params& p, int l) {
    unsigned char* ws = lnd(p.ws);
    const bf16_t* Y0 = (const bf16_t*)(ws + OFF_Y); const bf16_t* Y1 = Y0 + (size_t)TT * 512;
    const bf16_t* B0 = (const bf16_t*)(ws + OFF_BON); const bf16_t* B1 = B0 + (size_t)TT * 512;
    bf16_t* BR1 = (bf16_t*)(ws + OFF_BR + SZ_BR1);
    const float* lg = lnd(p.in[I_LNXG]) + l * 512; const float* lb = lnd(p.in[I_LNXB]) + l * 512;
    const size_t gt = (size_t)my_bid() * 512 + my_tid(), gn = (size_t)my_nb() * 512;
    for (size_t idx = gt; idx < (size_t)TT * 128; idx += gn) {
        const size_t off = idx * 4; const int c = (int)(off & 511);
        const uint2 ya = *(const uint2*)(Y0 + off), yb = *(const uint2*)(Y1 + off), ba = *(const uint2*)(B0 + off), bb = *(const uint2*)(B1 + off), gg = *(const uint2*)(BR1 + off);
        float y[4] = {bflo(ya.x) + bflo(yb.x), bfhi(ya.x) + bfhi(yb.x), bflo(ya.y) + bflo(yb.y), bfhi(ya.y) + bfhi(yb.y)};
        const float bon[4] = {bflo(ba.x) + bflo(bb.x), bfhi(ba.x) + bfhi(bb.x), bflo(ba.y) + bflo(bb.y), bfhi(ba.y) + bfhi(bb.y)};
        const float gt4[4] = {bflo(gg.x), bfhi(gg.x), bflo(gg.y), bfhi(gg.y)};
        const float mean = sum16(y[0] + y[1] + y[2] + y[3]) * (1.f / 64.f);
        float vs = 0.f;
#pragma unroll
        for (int e = 0; e < 4; ++e) { y[e] -= mean; vs += y[e] * y[e]; }
        const float rs = rsqrtf(sum16(vs) * (1.f / 64.f) + 64e-5f);
        float o[4];
#pragma unroll
        for (int e = 0; e < 4; ++e) o[e] = (y[e] * rs * lg[c + e] + lb[c + e] + bon[e]) * gt4[e];
        *(uint2*)(BR1 + off) = make_uint2(cvtpk(o[0], o[1]), cvtpk(o[2], o[3]));
    }
}

constexpr int NPH_LAYER = 12, NPHASE = 2 + NLAYER * NPH_LAYER;

__device__ void run_phase(const Params& p, int ph, unsigned char* smem) {
    unsigned char* ws = lnd(p.ws);
    float* lds = (float*)smem;
    const float* mod0 = (const float*)(ws + OFF_MOD);
    if (ph == 0) { prologue_mods(p, lds); __syncthreads(); convert_weights(p, 0, lds); return; }
    if (ph == 1) { rowwise(p, lnd(p.in[I_X]), lnd(p.in[I_CTX]), nullptr, nullptr, nullptr, nullptr, nullptr, 0, (bf16_t*)(ws + OFF_HX), lnd(p.in[I_NORMG]) + 0, mod0, 0, 1); return; }
    const int l = (ph - 2) / NPH_LAYER, st = (ph - 2) % NPH_LAYER;
    const float* modl = mod0 + (size_t)l * 9 * 6144;
    const float* ng = lnd(p.in[I_NORMG]) + (size_t)l * 4 * 1024;
    const float* xs_lat = l == 0 ? lnd(p.in[I_X]) : lnd(p.out); const float* xs_ctx = l == 0 ? lnd(p.in[I_CTX]) : (const float*)(ws + OFF_CTXRES);
    float* ctxres = (float*)(ws + OFF_CTXRES);
    const int G = my_nb(), c = my_bid();
    switch (st) {
    case 0: run_gemm(smem, (const bf16_t*)(ws + OFF_HX), 1024, (const bf16_t*)(ws + OFF_BTIN), NPROJ, 1024, 1 << 20, 0, FProj{ws}, G, c); break;
    case 1: phase_elem(p, l); break;
    case 2: phase_vt(p, lds); break;
    case 3: {
        const int nscan = G >= 192 ? 128 : G / 2;
        if (c < nscan) { for (int hd = c; hd < 128; hd += nscan) scan_head(p, l, hd, lds); }
        else { phase_attn(p, l, lds, c - nscan, G - nscan);
               run_gemm(smem, (const bf16_t*)(ws + OFF_SLORA), 256, (const bf16_t*)(ws + OFF_BTG2), 512, 256, 1 << 20, 0, FPlain{(bf16_t*)(ws + OFF_BR + SZ_BR1), 512}, G - nscan, c - nscan); }
        break; }
    case 4: phase_readout(p, l);
            rowwise(p, xs_lat, xs_ctx, nullptr, nullptr, nullptr, nullptr, nullptr, 0, (bf16_t*)(ws + OFF_HXB), ng, modl, 0, 1); break;
    case 5: run_gemm(smem, (const bf16_t*)(ws + OFF_HXB), 1024, (const bf16_t*)(ws + OFF_BTIN) + (size_t)NPROJ * 1024, 3072, 1024, 1 << 20, 0, FSig{(bf16_t*)(ws + OFF_G), 3072}, G, c); break;
    case 6: run_gemm(smem, (const bf16_t*)(ws + OFF_BR), 512, (const bf16_t*)(ws + OFF_BTUP), 3072, 512, 4, SZ_BR1, FMulG{(bf16_t*)(ws + OFF_G), 3072}, G, c); break;
    case 7: run_gemm(smem, (const bf16_t*)(ws + OFF_G), 3072, (const bf16_t*)(ws + OFF_BTO3), 1024, 3072, 1 << 20, 0, FPlain{(bf16_t*)(ws + OFF_HX), 1024}, G, c); break;
    case 8: rowwise(p, xs_lat, xs_ctx, lnd(p.out), ctxres, (const bf16_t*)(ws + OFF_HX), ng + 1024, modl, 2, (bf16_t*)(ws + OFF_HX), ng + 2048, modl, 3, 4); break;
    case 9: run_gemm(smem, (const bf16_t*)(ws + OFF_HX), 1024, (const bf16_t*)(ws + OFF_BTF1), 2 * DFF, 1024, 1 << 20, 0, FSwiglu{(bf16_t*)(ws + OFF_H)}, G, c); break;
    case 10: run_gemm(smem, (const bf16_t*)(ws + OFF_H), DFF, (const bf16_t*)(ws + OFF_BTF2), 1024, DFF, 1 << 20, 0, FPlain{(bf16_t*)(ws + OFF_BR), 1024}, G, c); break;
    case 11:
        if (l + 1 < NLAYER) {
            rowwise(p, lnd(p.out), ctxres, lnd(p.out), ctxres, (const bf16_t*)(ws + OFF_BR), ng + 3072, modl, 5, (bf16_t*)(ws + OFF_HX), lnd(p.in[I_NORMG]) + (size_t)(l + 1) * 4 * 1024, modl + 9 * 6144, 0, 1);
            __syncthreads(); convert_weights(p, l + 1, lds);
        } else rowwise(p, lnd(p.out), ctxres, lnd(p.out), ctxres, (const bf16_t*)(ws + OFF_BR), ng + 3072, modl, 5, nullptr, nullptr, nullptr, 0, 0);
        break;
    }
}

__global__ void __launch_bounds__(512, 2) fwd_megakernel(Params p) {
    extern __shared__ __attribute__((aligned(16))) unsigned char smem[];
    for (int ph = p.ph_lo; ph < p.ph_hi; ++ph) {
        run_phase(p, ph, smem);
        if (ph + 1 < p.ph_hi) { cg::this_grid().sync(); }
    }
}

extern "C" void kernel_launch(void* const* d_in, const int* in_sizes, int n_in, void* d_out, int out_size, void* d_ws, size_t ws_size, hipStream_t stream) {
    static int grid = 0;
    if (grid == 0) {
        if (n_in != 25 || ws_size < WS_END) { fprintf(stderr, "kernel_launch: need 25 inputs and %zu bytes of workspace (got %d, %zu)\n", (size_t)WS_END, n_in, ws_size); grid = -1; return; }
        int dev = 0, cus = 0, per_cu = 0;
        (void)hipGetDevice(&dev); (void)hipDeviceGetAttribute(&cus, hipDeviceAttributeMultiprocessorCount, dev);
        if (hipFuncSetAttribute((const void*)fwd_megakernel, hipFuncAttributeMaxDynamicSharedMemorySize, LDS_BYTES) != hipSuccess) { fprintf(stderr, "kernel_launch: hipFuncSetAttribute failed\n"); grid = -1; return; }
        if (hipOccupancyMaxActiveBlocksPerMultiprocessor(&per_cu, (const void*)fwd_megakernel, 512, LDS_BYTES) != hipSuccess || per_cu < 1) { fprintf(stderr, "kernel_launch: occupancy query gave %d\n", per_cu); per_cu = 1; }
        (void)hipGetLastError();
        grid = cus * 1;
    }
    if (grid < 0) return;
    Params p{};
    for (int i = 0; i < 25; ++i) p.in[i] = (const float*)d_in[i];
    p.out = (float*)d_out; p.ws = (unsigned char*)d_ws;
#if MULTI_LAUNCH
    for (int ph = 0; ph < NPHASE; ++ph) { p.ph_lo = ph; p.ph_hi = ph + 1; hipLaunchKernelGGL(fwd_megakernel, dim3(grid), dim3(512), LDS_BYTES, stream, p); }
#else
    p.ph_lo = 0; p.ph_hi = NPHASE;
    void* args[] = {&p};
    hipError_t e = hipLaunchCooperativeKernel((const void*)fwd_megakernel, dim3(grid), dim3(512), args, LDS_BYTES, stream);
    if (e != hipSuccess) fprintf(stderr, "cooperative launch failed: %s (grid %d)\n", hipGetErrorString(e), grid);
#endif
}
```

```cpp
#include <hip/hip_runtime.h>
#include <hip/hip_cooperative_groups.h>
#include <cstdio>
namespace cg = cooperative_groups;

#ifndef MULTI_LAUNCH
#define MULTI_LAUNCH 0
#endif

typedef unsigned short bf16_t;
typedef short bf16x8 __attribute__((ext_vector_type(8)));
typedef float f32x4 __attribute__((ext_vector_type(4)));

constexpr int NB = 8, SEQ = 8192, DM = 1024, CTXL = 256;
constexpr int TL = NB * SEQ, TC = NB * CTXL, TT = TL + TC;
constexpr int DIN = 7936, DFF = 2816, NPROJ = 4864, MIXW = 512;
constexpr int NLAYER = 2;

constexpr size_t SZ_BTIN = (size_t)DIN * 1024 * 2, SZ_BTUP = (size_t)3072 * 512 * 2, SZ_BTO3 = (size_t)1024 * 3072 * 2,
                 SZ_BTF1 = (size_t)5632 * 1024 * 2, SZ_BTF2 = (size_t)1024 * 2816 * 2, SZ_BTG2 = (size_t)512 * 256 * 2;
constexpr size_t OFF_BTIN = 0, OFF_BTUP = OFF_BTIN + SZ_BTIN, OFF_BTO3 = OFF_BTUP + SZ_BTUP, OFF_BTF1 = OFF_BTO3 + SZ_BTO3,
                 OFF_BTF2 = OFF_BTF1 + SZ_BTF1, OFF_BTG2 = OFF_BTF2 + SZ_BTF2, OFF_MISC = OFF_BTG2 + SZ_BTG2;
constexpr size_t OFF_MOD = OFF_MISC;
constexpr size_t OFF_ROPE = OFF_MOD + (size_t)2 * 9 * 6144 * 4;
constexpr size_t OFF_CTXRES = OFF_MISC + (1u << 20);
constexpr size_t OFF_HX = OFF_CTXRES + (size_t)TC * 1024 * 4;
constexpr size_t SZ_HX = (size_t)TT * 1024 * 2;
constexpr size_t SZ_SEG = (size_t)TT * 1536 * 2;
constexpr size_t OFF_SCONV = OFF_HX + SZ_HX, OFF_SATTN = OFF_SCONV + SZ_SEG, OFF_SRKV = OFF_SATTN + SZ_SEG, OFF_SLORA = OFF_SRKV + SZ_SEG;
constexpr size_t OFF_BR = OFF_SLORA + (size_t)TT * 256 * 2;
constexpr size_t SZ_BR1 = (size_t)TT * 512 * 2;
constexpr size_t WS_END = OFF_BR + 3 * SZ_BR1;
constexpr size_t OFF_BON = OFF_SCONV;
constexpr size_t OFF_VT = OFF_SCONV + 2 * SZ_BR1;
constexpr size_t OFF_VTC = OFF_VT + (size_t)TL * 512 * 2;
constexpr size_t OFF_Y = OFF_HX;
constexpr size_t OFF_G = OFF_SCONV;
constexpr size_t OFF_H = OFF_SCONV;
constexpr size_t OFF_HXB = OFF_SRKV;

constexpr int LDS_BYTES = 144 * 1024;

struct Params {
    const float* in[25];
    float* out;
    unsigned char* ws;
    int ph_lo, ph_hi;
};
enum { I_X = 0, I_C, I_CTX, I_CCTX, I_WADA, I_BADA, I_NORMG, I_WIN, I_CONVW, I_MU, I_W0, I_W2, I_A0, I_A2, I_KK, I_KA, I_RK, I_G2, I_LNXG, I_LNXB, I_RPB, I_WUP, I_WO, I_WF1, I_WF2 };

__device__ __forceinline__ float bf2f(unsigned v16) { return __uint_as_float(v16 << 16); }
__device__ __forceinline__ float bflo(unsigned u) { return __uint_as_float(u << 16); }
__device__ __forceinline__ float bfhi(unsigned u) { return __uint_as_float(u & 0xffff0000u); }
__device__ __forceinline__ unsigned cvtpk(float lo, float hi) { unsigned r; asm volatile("v_cvt_pk_bf16_f32 %0, %1, %2" : "=v"(r) : "v"(lo), "v"(hi)); return r; }
__device__ __forceinline__ bf16_t f2bf(float f) { return (bf16_t)(cvtpk(f, 0.f) & 0xffffu); }
template <int CTRL> __device__ __forceinline__ float dpp(float x) { return __builtin_bit_cast(float, __builtin_amdgcn_mov_dpp(__builtin_bit_cast(int, x), CTRL, 0xf, 0xf, true)); }
constexpr int XOR1 = 0xB1, XOR2 = 0x4E, XOR7 = 0x141, XOR8 = 0x128;
__device__ __forceinline__ float sum8(float x) { x += dpp<XOR1>(x); x += dpp<XOR2>(x); x += dpp<XOR7>(x); return x; }
__device__ __forceinline__ float sum16(float x) { x = sum8(x); x += dpp<XOR8>(x); return x; }
__device__ __forceinline__ float xrow16_max(float x) {
    auto s = __builtin_amdgcn_permlane16_swap(__float_as_uint(x), __float_as_uint(x), false, false);
    x = fmaxf(__uint_as_float(s[0]), __uint_as_float(s[1]));
    auto t = __builtin_amdgcn_permlane32_swap(__float_as_uint(x), __float_as_uint(x), false, false);
    return fmaxf(__uint_as_float(t[0]), __uint_as_float(t[1]));
}
__device__ __forceinline__ float xrow16_sum(float x) {
    auto s = __builtin_amdgcn_permlane16_swap(__float_as_uint(x), __float_as_uint(x), false, false);
    x = __uint_as_float(s[0]) + __uint_as_float(s[1]);
    auto t = __builtin_amdgcn_permlane32_swap(__float_as_uint(x), __float_as_uint(x), false, false);
    return __uint_as_float(t[0]) + __uint_as_float(t[1]);
}
__device__ __forceinline__ float wave_sum(float x) { return xrow16_sum(sum16(x)); }
template <class T> __device__ __forceinline__ T* lnd(T* q) { const unsigned long long v = (unsigned long long)q; unsigned lo = __builtin_amdgcn_readfirstlane((unsigned)v), hi = __builtin_amdgcn_readfirstlane((unsigned)(v >> 32)); asm volatile("" : "+s"(lo), "+s"(hi)); return (T*)(((unsigned long long)hi << 32) | lo); }
__device__ __forceinline__ int my_tid() { int t = threadIdx.x; asm volatile("" : "+v"(t)); return t; }
__device__ __forceinline__ int my_bid() { int t = __builtin_amdgcn_readfirstlane(blockIdx.x); asm volatile("" : "+s"(t)); return t; }
__device__ __forceinline__ int my_nb() { int t = __builtin_amdgcn_readfirstlane(gridDim.x); asm volatile("" : "+s"(t)); return t; }
__device__ __forceinline__ float sigmoidf_(float x) { return 1.f / (1.f + __expf(-x)); }
__device__ __forceinline__ float tanh_fast(float x) { return 1.f - 2.f / (1.f + __expf(2.f * x)); }

namespace pg8 {
#define PG8_LAS __attribute__((address_space(3)))
constexpr int BM = 256, BK = 64, HALF = 128, HTB = HALF * BK * 2, STAGE_BYTES = 8 * HTB, NXCD = 8, WGM = 8;
__host__ __device__ __forceinline__ int lds_byte(int r, int c) { const int st = (r >> 4) * 2 + (c >> 5), rr = r & 15, cc = c & 31, ob = rr * 64 + cc * 2; return st * 1024 + (ob ^ (((ob >> 9) & 1) << 5)); }
__host__ __device__ __forceinline__ void stage_rc(int b, int& R, int& C) { const int st = b / 1024, sb = b % 1024, swz = sb ^ (((sb >> 9) & 1) << 5); R = (st >> 1) * 16 + swz / 64; C = (st & 1) * 32 + (swz % 64) / 2; }
struct Unit { int pm, pn; };
struct Gemm { const bf16_t* A; const bf16_t* Bt; int M, N, K, lda; int a_div; size_t a_bstride; };
struct StaticOrder {
    int nM, nN, nwg, G, c;
    __host__ __device__ void init(int M, int N, int G_, int c_) { nM = M / BM; nN = N / BM; nwg = nM * nN; G = G_; c = c_; }
    __host__ __device__ bool next(int i, Unit& u) const {
        const long L = (long)i * G + c; if (L >= nwg) return false;
        int wgid = (int)L; { const int q = nwg / NXCD, r = nwg % NXCD, xcd = wgid % NXCD, off = wgid / NXCD; wgid = (xcd < r ? xcd * (q + 1) : r * (q + 1) + (xcd - r) * q) + off; }
        const int nig = WGM * nN, gid = wgid / nig, fm = gid * WGM, gsz = (nM - fm) < WGM ? (nM - fm) : WGM;
        u.pm = fm + ((wgid % nig) % gsz); u.pn = (wgid % nig) / gsz; return true;
    }
};

template <class Epi>
__device__ __forceinline__ void gemm_phase(PG8_LAS unsigned char* lds, const Gemm g, const StaticOrder& S, const Epi& E) {
    const int tid = my_tid(), wid = __builtin_amdgcn_readfirstlane(tid >> 6), lane = tid & 63, wr = wid >> 2, wc = wid & 3, fr = lane & 15, fq = lane >> 4;
    const int K = g.K, nt = K / BK, lda = g.lda;
    unsigned voffA[2], voffB[2];
#pragma unroll
    for (int i = 0; i < 2; ++i) { int R, C; stage_rc(tid * 16 + i * 8192, R, C);
        voffA[i] = (unsigned)(R * lda + C) * 2u; voffB[i] = (unsigned)(R * K + C) * 2u; }
    const size_t kstep = (size_t)(BK * 2);
    const size_t hsA = (size_t)HALF * lda * 2, hsB = (size_t)HALF * K * 2;
    const size_t tsA = 2 * hsA, tsB = 2 * hsB;
    const unsigned ldsw = (unsigned)wid * 1024u;
    const int aoff = lds_byte(wr * 64 + fr, fq * 8), boff = lds_byte(wc * 32 + fr, fq * 8);
#define PG8_SA(b, h) (((b) * 2 + (h)) * HTB)
#define PG8_SB(b, h) ((4 + (b) * 2 + (h)) * HTB)
#define PG8_STAGE(bufoff, gbase, voff) do { _Pragma("unroll") for (int _i = 0; _i < 2; ++_i) \
        __builtin_amdgcn_global_load_lds((const unsigned*)((const char*)(gbase) + (voff)[_i]), (PG8_LAS unsigned*)(lds + (bufoff) + ldsw + _i * 8192), 16, 0, 0); } while (0)
#define PG8_LDA(dst, b, h) do { _Pragma("unroll") for (int m = 0; m < 4; ++m) _Pragma("unroll") for (int k = 0; k < 2; ++k) dst[m][k] = *(const PG8_LAS bf16x8*)(lds + PG8_SA(b, h) + aoff + m * 2048 + k * 1024); } while (0)
#define PG8_LDB(dst, b, h) do { _Pragma("unroll") for (int n = 0; n < 2; ++n) _Pragma("unroll") for (int k = 0; k < 2; ++k) dst[n][k] = *(const PG8_LAS bf16x8*)(lds + PG8_SB(b, h) + boff + n * 2048 + k * 1024); } while (0)
#define PG8_MMA(ai, bj, At, Bt) do { __builtin_amdgcn_s_setprio(1); _Pragma("unroll") for (int m = 0; m < 4; ++m) _Pragma("unroll") for (int n = 0; n < 2; ++n) _Pragma("unroll") for (int k = 0; k < 2; ++k) \
        acc[ai][bj][m][n] = __builtin_amdgcn_mfma_f32_16x16x32_bf16(Bt[n][k], At[m][k], acc[ai][bj][m][n], 0, 0, 0); __builtin_amdgcn_s_setprio(0); } while (0)
#define PG8_WAIT_V(n) asm volatile("s_waitcnt vmcnt(" #n ")" ::: "memory")
#define PG8_WAIT_L(n) asm volatile("s_waitcnt lgkmcnt(" #n ")" ::: "memory")
#define PG8_BAR __builtin_amdgcn_s_barrier()
#define PG8_SCHED __builtin_amdgcn_sched_barrier(0)
#define PG8_APTR(u) ((const char*)g.A + (size_t)((u).pn / g.a_div) * g.a_bstride + (size_t)(u).pm * tsA)
    Unit cur, nxt; int ui = 0;
    if (!S.next(0, cur)) return;
    f32x4 acc[2][2][4][2];
#pragma unroll
    for (int a = 0; a < 2; ++a)
#pragma unroll
        for (int b = 0; b < 2; ++b)
#pragma unroll
            for (int m = 0; m < 4; ++m)
#pragma unroll
                for (int n = 0; n < 2; ++n) acc[a][b][m][n] = (f32x4){0.f, 0.f, 0.f, 0.f};
    bf16x8 At[4][2], B0[2][2], B1[2][2];
    const char* cA = PG8_APTR(cur); const char* cB = (const char*)g.Bt + (size_t)cur.pn * tsB;
    PG8_STAGE(PG8_SB(0, 0), cB, voffB); PG8_STAGE(PG8_SA(0, 0), cA, voffA); PG8_STAGE(PG8_SB(0, 1), cB + hsB, voffB); PG8_STAGE(PG8_SA(0, 1), cA + hsA, voffA);
    if (wr == 1) PG8_BAR;
    PG8_WAIT_V(4); PG8_BAR;
    PG8_STAGE(PG8_SB(1, 0), cB + kstep, voffB); PG8_STAGE(PG8_SA(1, 0), cA + kstep, voffA); PG8_STAGE(PG8_SB(1, 1), cB + hsB + kstep, voffB);
    PG8_WAIT_V(6); PG8_BAR;
    for (;;) {
        const bool has_next = S.next(ui + 1, nxt);
        const char* nA = has_next ? PG8_APTR(nxt) : cA; const char* nB = has_next ? (const char*)g.Bt + (size_t)nxt.pn * tsB : cB;
        for (int t = 0; t < nt; t += 2) {
            const bool last = (t == nt - 2);
            const char* a1 = cA + (size_t)(t + 1) * kstep;
            const char* a2 = last ? nA : cA + (size_t)(t + 2) * kstep; const char* b2 = last ? nB : cB + (size_t)(t + 2) * kstep;
            const char* a3 = a2 + kstep; const char* b3 = b2 + kstep;
            PG8_LDB(B0, 0, 0); PG8_SCHED; PG8_LDA(At, 0, 0); PG8_STAGE(PG8_SA(1, 1), a1 + hsA, voffA);
            PG8_WAIT_L(8); PG8_BAR; PG8_WAIT_L(0); PG8_MMA(0, 0, At, B0); PG8_BAR; PG8_SCHED;
            PG8_LDB(B1, 0, 1); PG8_STAGE(PG8_SB(0, 0), b2, voffB);
            PG8_BAR; PG8_WAIT_L(0); PG8_MMA(0, 1, At, B1); PG8_BAR;
            PG8_LDA(At, 0, 1); PG8_STAGE(PG8_SA(0, 0), a2, voffA);
            PG8_BAR; PG8_WAIT_L(0); PG8_MMA(1, 0, At, B0); PG8_BAR; PG8_SCHED;
            PG8_STAGE(PG8_SB(0, 1), b2 + hsB, voffB);
            PG8_WAIT_V(6); PG8_BAR; PG8_MMA(1, 1, At, B1); PG8_BAR;
            PG8_LDB(B0, 1, 0); PG8_SCHED; PG8_LDA(At, 1, 0); PG8_STAGE(PG8_SA(0, 1), a2 + hsA, voffA);
            PG8_WAIT_L(8); PG8_BAR; PG8_WAIT_L(0); PG8_MMA(0, 0, At, B0); PG8_BAR; PG8_SCHED;
            PG8_LDB(B1, 1, 1); PG8_STAGE(PG8_SB(1, 0), b3, voffB);
            PG8_BAR; PG8_WAIT_L(0); PG8_MMA(0, 1, At, B1); PG8_BAR;
            PG8_LDA(At, 1, 1); PG8_STAGE(PG8_SA(1, 0), a3, voffA);
            PG8_BAR; PG8_WAIT_L(0); PG8_MMA(1, 0, At, B0); PG8_BAR; PG8_SCHED;
            PG8_STAGE(PG8_SB(1, 1), b3 + hsB, voffB);
            PG8_WAIT_V(6); PG8_BAR; PG8_MMA(1, 1, At, B1); PG8_BAR;
        }
        E(acc, cur, wr, wc, fr, fq);
        if (!has_next) break;
#pragma unroll
        for (int a = 0; a < 2; ++a)
#pragma unroll
            for (int b = 0; b < 2; ++b)
#pragma unroll
                for (int m = 0; m < 4; ++m)
#pragma unroll
                    for (int n = 0; n < 2; ++n) acc[a][b][m][n] = (f32x4){0.f, 0.f, 0.f, 0.f};
        cur = nxt; cA = nA; cB = nB; ++ui;
    }
    PG8_WAIT_V(0);
    if (wr == 0) PG8_BAR;
    PG8_BAR;
#undef PG8_SA
#undef PG8_SB
#undef PG8_STAGE
#undef PG8_LDA
#undef PG8_LDB
#undef PG8_MMA
#undef PG8_WAIT_V
#undef PG8_WAIT_L
#undef PG8_BAR
#undef PG8_SCHED
#undef PG8_APTR
}

template <class F> struct EpiT {
    F f;
    __device__ __forceinline__ void operator()(const f32x4 (&acc)[2][2][4][2], const Unit& u, int wr, int wc, int fr, int fq) const {
        const int row0 = u.pm * BM + wr * 64 + fr;
#pragma unroll
        for (int ai = 0; ai < 2; ++ai)
#pragma unroll
            for (int m = 0; m < 4; ++m) {
                const int row = row0 + ai * HALF + m * 16;
#pragma unroll
                for (int bj = 0; bj < 2; ++bj) f(row, u.pn, bj * HALF + wc * 32 + fq * 4, acc[ai][bj][m][0], acc[ai][bj][m][1]);
            }
    }
};
}


__device__ __forceinline__ void st4bf(bf16_t* p, f32x4 v) { *(uint2*)p = make_uint2(cvtpk(v[0], v[1]), cvtpk(v[2], v[3])); }

struct FProj {
    unsigned char* ws;
    __device__ __forceinline__ void operator()(int row, int pn, int cw, f32x4 v0, f32x4 v1) const {
        bf16_t* p;
        if (pn < 18) { const int seg = pn / 6; p = (bf16_t*)(ws + OFF_SCONV + (size_t)seg * SZ_SEG) + (size_t)row * 1536 + (pn - seg * 6) * 256 + cw; }
        else p = (bf16_t*)(ws + OFF_SLORA) + (size_t)row * 256 + cw;
        st4bf(p, v0); st4bf(p + 16, v1);
    }
};
struct FPlain { bf16_t* O; int ld;
    __device__ __forceinline__ void operator()(int row, int pn, int cw, f32x4 v0, f32x4 v1) const {
        bf16_t* p = O + (size_t)row * ld + pn * 256 + cw; st4bf(p, v0); st4bf(p + 16, v1); } };
struct FSig { bf16_t* O; int ld;
    __device__ __forceinline__ void operator()(int row, int pn, int cw, f32x4 v0, f32x4 v1) const {
        bf16_t* p = O + (size_t)row * ld + pn * 256 + cw;
#pragma unroll
        for (int j = 0; j < 4; ++j) { v0[j] = sigmoidf_(v0[j]); v1[j] = sigmoidf_(v1[j]); }
        st4bf(p, v0); st4bf(p + 16, v1); } };
struct FMulG { bf16_t* G; int ld;
    __device__ __forceinline__ void operator()(int row, int pn, int cw, f32x4 v0, f32x4 v1) const {
        bf16_t* p = G + (size_t)row * ld + pn * 256 + cw;
        const uint2 g0 = *(const uint2*)p, g1 = *(const uint2*)(p + 16);
        v0[0] *= bflo(g0.x); v0[1] *= bfhi(g0.x); v0[2] *= bflo(g0.y); v0[3] *= bfhi(g0.y);
        v1[0] *= bflo(g1.x); v1[1] *= bfhi(g1.x); v1[2] *= bflo(g1.y); v1[3] *= bfhi(g1.y);
        st4bf(p, v0); st4bf(p + 16, v1); } };
struct FSwiglu { bf16_t* H;
    __device__ __forceinline__ void operator()(int row, int pn, int cw, f32x4 a, f32x4 b) const {
        const int hc = pn * 128 + (cw >> 5) * 16 + (cw & 15);
        f32x4 o;
#pragma unroll
        for (int j = 0; j < 4; ++j) o[j] = a[j] * sigmoidf_(a[j]) * b[j];
        st4bf(H + (size_t)row * DFF + hc, o); } };

template <class F>
__device__ __forceinline__ void run_gemm(unsigned char* smem, const bf16_t* A, int lda, const bf16_t* Bt, int N, int K, int a_div, size_t a_bstride, const F& f, int G, int c) {
    pg8::Gemm g; g.A = A; g.Bt = Bt; g.M = TT; g.N = N; g.K = K; g.lda = lda; g.a_div = a_div; g.a_bstride = a_bstride;
    pg8::StaticOrder S; S.init(TT, N, G, c);
    pg8::EpiT<F> E{f};
    pg8::gemm_phase(( PG8_LAS unsigned char*)smem, g, S, E);
}

__device__ __forceinline__ int mapcol(int mode, int n) {
    if (mode == 1) return n < 1536 ? n : (n < 3072 ? n + 1792 : (n < 4864 ? n - 1536 : n));
    if (mode == 2) { const int g = n >> 5, w = n & 31; return w < 16 ? 16 * g + w : DFF + 16 * g + (w - 16); }
    return n;
}
__device__ void xpose(const float* __restrict__ src, int src_ld, int K, int N, bf16_t* __restrict__ dst, int dst_ld, int dst_koff, int mode, float* tile, int rot) {
    const int ntk = K / 64, ntn = N / 64, tid = my_tid();
    const int bid = (int)((my_bid() + (unsigned)rot) % my_nb());
    for (int t = bid; t < ntk * ntn; t += my_nb()) {
        const int tk = t % ntk, tn = t / ntk;
#pragma unroll
        for (int p = 0; p < 8; ++p) { const int k = p * 8 + (tid >> 6), n = tid & 63;
            tile[k * 65 + n] = src[(size_t)(tk * 64 + k) * src_ld + mapcol(mode, tn * 64 + n)]; }
        __syncthreads();
#pragma unroll
        for (int p = 0; p < 8; ++p) { const int n = p * 8 + (tid >> 6), k = tid & 63;
            dst[(size_t)(tn * 64 + n) * dst_ld + dst_koff + tk * 64 + k] = f2bf(tile[k * 65 + n]); }
        __syncthreads();
    }
}
__device__ void convert_weights(const Params& p, int l, float* tile) {
    unsigned char* ws = lnd(p.ws);
    xpose(lnd(p.in[I_WIN]) + (size_t)l * 1024 * DIN, DIN, 1024, DIN, (bf16_t*)(ws + OFF_BTIN), 1024, 0, 1, tile, 0);
    for (int b = 0; b < 3; ++b) xpose(lnd(p.in[I_WUP]) + ((size_t)l * 3 + b) * 512 * 1024, 1024, 512, 1024, (bf16_t*)(ws + OFF_BTUP) + (size_t)b * 1024 * 512, 512, 0, 0, tile, 64 + b * 64);
    for (int b = 0; b < 3; ++b) xpose(lnd(p.in[I_WO]) + (size_t)l * 1024 * 1024, 1024, 1024, 1024, (bf16_t*)(ws + OFF_BTO3), 3072, b * 1024, 0, tile, 0);
    xpose(lnd(p.in[I_WF1]) + (size_t)l * 1024 * 2 * DFF, 2 * DFF, 1024, 2 * DFF, (bf16_t*)(ws + OFF_BTF1), 1024, 0, 2, tile, 0);
    xpose(lnd(p.in[I_WF2]) + (size_t)l * DFF * 1024, 1024, DFF, 1024, (bf16_t*)(ws + OFF_BTF2), DFF, 0, 0, tile, 128);
    xpose(lnd(p.in[I_G2]) + (size_t)l * 128 * 512, 512, 128, 512, (bf16_t*)(ws + OFF_BTG2), 256, 128, 0, tile, 200);
    bf16_t* g2 = (bf16_t*)(ws + OFF_BTG2);
    for (int i = my_bid() * 512 + my_tid(); i < 512 * 128; i += my_nb() * 512) g2[(i >> 7) * 256 + (i & 127)] = 0;
}

__device__ void prologue_mods(const Params& p, float* lds) {
    float* sc = lds;
    float* red = lds + 9 * 1024;
    const int tid = my_tid();
    for (int e = tid; e < 9 * 1024; e += 512) { const int v = e >> 10, k = e & 1023; const float x = v < 8 ? lnd(p.in[I_C])[v * 1024 + k] : lnd(p.in[I_CCTX])[k]; sc[e] = x * sigmoidf_(x); }
    __syncthreads();
    const int kg = tid >> 4, cl = tid & 15;
    float* mod = (float*)(lnd(p.ws) + OFF_MOD);
    for (int cgp = my_bid(); cgp < 2 * 384; cgp += my_nb()) {
        const int l = cgp / 384, col = (cgp % 384) * 16 + cl;
        float acc[9];
#pragma unroll
        for (int v = 0; v < 9; ++v) acc[v] = 0.f;
        const float* w = lnd(p.in[I_WADA]) + (size_t)l * 1024 * 6144 + col;
        for (int k = kg * 32; k < kg * 32 + 32; ++k) { const float wv = w[(size_t)k * 6144];
#pragma unroll
            for (int v = 0; v < 9; ++v) acc[v] += sc[v * 1024 + k] * wv; }
#pragma unroll
        for (int v = 0; v < 9; ++v) red[(kg * 16 + cl) * 9 + v] = acc[v];
        __syncthreads();
        if (tid < 144) { const int c2 = tid / 9, v = tid % 9; float s = 0.f;
            for (int g = 0; g < 32; ++g) s += red[(g * 16 + c2) * 9 + v];
            const int cc = (cgp % 384) * 16 + c2;
            mod[((size_t)l * 9 + v) * 6144 + cc] = s + lnd(p.in[I_BADA])[l * 6144 + cc]; }
        __syncthreads();
    }
    float* rope = (float*)(lnd(p.ws) + OFF_ROPE);
    for (int i = my_bid() * 512 + tid; i < 192 * 16; i += my_nb() * 512) {
        const int pos = i >> 4, j = i & 15; const int pp = pos < 128 ? pos : pos - 128;
        const float fr = exp2f(-(float)j * 0.83048202372f);
        const float ang = (float)pp * fr;
        rope[i] = __cosf(ang); rope[192 * 16 + i] = __sinf(ang);
    }
}

__device__ void rowwise(const Params& p, const float* xs_lat, const float* xs_ctx, float* xd_lat, float* xd_ctx,
                        const bf16_t* Y, const float* gy, const float* modY, int gate_chunk,
                        bf16_t* HXo, const float* gh, const float* modH, int sh_chunk, int sc_chunk) {
    const int tid = my_tid(); const int lane = tid & 63, gw = my_bid() * 8 + (tid >> 6), nw = my_nb() * 8;
    for (int row = gw; row < TT; row += nw) {
        const bool lat = row < TL;
        const int v = lat ? (row >> 13) : 8;
        const float* xr = lat ? xs_lat + (size_t)row * 1024 : xs_ctx + (size_t)(row - TL) * 1024;
        float4 x[4];
#pragma unroll
        for (int i = 0; i < 4; ++i) x[i] = *(const float4*)(xr + i * 256 + lane * 4);
        if (Y) {
            float y[16]; float ss = 0.f;
#pragma unroll
            for (int i = 0; i < 4; ++i) { const uint2 u = *(const uint2*)(Y + (size_t)row * 1024 + i * 256 + lane * 4);
                y[4 * i] = bflo(u.x); y[4 * i + 1] = bfhi(u.x); y[4 * i + 2] = bflo(u.y); y[4 * i + 3] = bfhi(u.y); }
#pragma unroll
            for (int i = 0; i < 16; ++i) ss += y[i] * y[i];
            ss = wave_sum(ss);
            const float rn = rsqrtf(ss * (1.f / 1024.f) + 1e-6f);
            const float* gt = modY + (size_t)v * 6144 + gate_chunk * 1024;
#pragma unroll
            for (int i = 0; i < 4; ++i) { const int c = i * 256 + lane * 4; const float4 g = *(const float4*)(gy + c), t = *(const float4*)(gt + c);
                x[i].x += t.x * (y[4 * i] * rn * g.x); x[i].y += t.y * (y[4 * i + 1] * rn * g.y); x[i].z += t.z * (y[4 * i + 2] * rn * g.z); x[i].w += t.w * (y[4 * i + 3] * rn * g.w); }
            float* xw = lat ? xd_lat + (size_t)row * 1024 : xd_ctx + (size_t)(row - TL) * 1024;
#pragma unroll
            for (int i = 0; i < 4; ++i) *(float4*)(xw + i * 256 + lane * 4) = x[i];
        }
        if (HXo) {
            float ss = 0.f;
#pragma unroll
            for (int i = 0; i < 4; ++i) ss += x[i].x * x[i].x + x[i].y * x[i].y + x[i].z * x[i].z + x[i].w * x[i].w;
            ss = wave_sum(ss);
            const float rn = rsqrtf(ss * (1.f / 1024.f) + 1e-6f);
            const float* sh = modH + (size_t)v * 6144 + sh_chunk * 1024; const float* scp = modH + (size_t)v * 6144 + sc_chunk * 1024;
#pragma unroll
            for (int i = 0; i < 4; ++i) { const int c = i * 256 + lane * 4; const float4 g = *(const float4*)(gh + c), a = *(const float4*)(scp + c), b = *(const float4*)(sh + c);
                const float o0 = x[i].x * rn * g.x * (1.f + a.x) + b.x, o1 = x[i].y * rn * g.y * (1.f + a.y) + b.y, o2 = x[i].z * rn * g.z * (1.f + a.z) + b.z, o3 = x[i].w * rn * g.w * (1.f + a.w) + b.w;
                *(uint2*)(HXo + (size_t)row * 1024 + c) = make_uint2(cvtpk(o0, o1), cvtpk(o2, o3)); }
        }
    }
}

__device__ __forceinline__ void unpack8(const uint4 u, float* f) { f[0] = bflo(u.x); f[1] = bfhi(u.x); f[2] = bflo(u.y); f[3] = bfhi(u.y); f[4] = bflo(u.z); f[5] = bfhi(u.z); f[6] = bflo(u.w); f[7] = bfhi(u.w); }
__device__ __forceinline__ uint4 pack8(const float* f) { return make_uint4(cvtpk(f[0], f[1]), cvtpk(f[2], f[3]), cvtpk(f[4], f[5]), cvtpk(f[6], f[7])); }

__device__ void phase_elem(const Params& p, int l) {
    unsigned char* ws = lnd(p.ws);
    const bf16_t* SC = (const bf16_t*)(ws + OFF_SCONV);
    bf16_t* SA = (bf16_t*)(ws + OFF_SATTN);
    bf16_t* SL = (bf16_t*)(ws + OFF_SLORA);
    bf16_t* BR0 = (bf16_t*)(ws + OFF_BR);
    bf16_t* BR2 = (bf16_t*)(ws + OFF_BR + 2 * SZ_BR1);
    const float* cw = lnd(p.in[I_CONVW]) + (size_t)l * 3 * 512;
    const float* rope = (const float*)(ws + OFF_ROPE);
    const size_t gt = (size_t)my_bid() * 512 + my_tid(), gn = (size_t)my_nb() * 512;
    for (size_t idx = gt; idx < (size_t)TT * 64; idx += gn) {
        const int row = (int)(idx >> 6), c8 = (int)(idx & 63) * 8;
        bool hp, hn;
        if (row < TL) { const int t = row & 8191; hp = t > 0; hn = t < 8191; } else { const int t = (row - TL) & 255; hp = t > 0; hn = t < 255; }
        float z[3][8];
#pragma unroll
        for (int o = 0; o < 3; ++o) {
            const bool ok = o == 1 || (o == 0 ? hp : hn);
            if (ok) { const bf16_t* r = SC + (size_t)(row + o - 1) * 1536; float c[8], h[8]; unpack8(*(const uint4*)(r + 512 + c8), c); unpack8(*(const uint4*)(r + 1024 + c8), h);
#pragma unroll
                for (int e = 0; e < 8; ++e) z[o][e] = c[e] * h[e]; }
            else {
#pragma unroll
                for (int e = 0; e < 8; ++e) z[o][e] = 0.f; }
        }
        float bg[8], o8[8]; unpack8(*(const uint4*)(SC + (size_t)row * 1536 + c8), bg);
#pragma unroll
        for (int e = 0; e < 8; ++e) o8[e] = bg[e] * (cw[c8 + e] * z[0][e] + cw[512 + c8 + e] * z[1][e] + cw[1024 + c8 + e] * z[2][e]);
        *(uint4*)(BR0 + (size_t)row * 512 + c8) = pack8(o8);
    }
    for (size_t idx = gt; idx < (size_t)TL * 64; idx += gn) {
        const int row = (int)(idx >> 6), rem = (int)(idx & 63);
        const int which = rem >> 5, head = (rem >> 2) & 7, part = (rem >> 1) & 1, sub = rem & 1;
        const int t = row & 8191; const int pos = part == 0 ? (t >> 6) : 128 + (t & 63);
        const float* cs = rope + pos * 16 + sub * 8; const float* sn = cs + 192 * 16;
        const int off = which * 512 + head * 64 + part * 32 + sub * 8;
        const bf16_t* src = SA + (size_t)row * 1536 + off;
        float x1[8], x2[8], o1[8], o2[8]; unpack8(*(const uint4*)src, x1); unpack8(*(const uint4*)(src + 16), x2);
#pragma unroll
        for (int e = 0; e < 8; ++e) { o1[e] = x1[e] * cs[e] - x2[e] * sn[e]; o2[e] = x1[e] * sn[e] + x2[e] * cs[e]; }
        bf16_t* dst = which == 0 ? BR2 + (size_t)row * 512 + head * 64 + part * 32 + sub * 8 : SA + (size_t)row * 1536 + off;
        *(uint4*)dst = pack8(o1); *(uint4*)(dst + 16) = pack8(o2);
    }
    for (size_t idx = gt; idx < (size_t)TT * 16; idx += gn) {
        const int row = (int)(idx >> 4), c8 = 128 + (int)(idx & 15) * 8;
        bf16_t* q = SL + (size_t)row * 256 + c8; float f[8]; unpack8(*(const uint4*)q, f);
#pragma unroll
        for (int e = 0; e < 8; ++e) f[e] = sigmoidf_(f[e]);
        *(uint4*)q = pack8(f);
    }
}

__device__ void phase_vt(const Params& p, float* lds) {
    unsigned char* ws = lnd(p.ws);
    const bf16_t* SA = (const bf16_t*)(ws + OFF_SATTN);
    bf16_t* VT = (bf16_t*)(ws + OFF_VT); bf16_t* VTC = (bf16_t*)(ws + OFF_VTC);
    bf16_t* tile = (bf16_t*)lds;
    const int tid = my_tid();
    const int nlat = 8 * 8 * 128, nall = nlat + 8 * 8 * 4;
    for (int it = my_bid(); it < nall; it += my_nb()) {
        int b, h, t0, rowbase, tlen; bf16_t* dst;
        if (it < nlat) { b = it >> 10; h = (it >> 7) & 7; t0 = (it & 127) * 64; rowbase = b * 8192 + t0; tlen = 8192; dst = VT + ((size_t)(b * 8 + h) * 64) * 8192 + t0; }
        else { const int j = it - nlat; b = j >> 5; h = (j >> 2) & 7; t0 = (j & 3) * 64; rowbase = TL + b * 256 + t0; tlen = 256; dst = VTC + ((size_t)(b * 8 + h) * 64) * 256 + t0; }
        { const int tk = tid >> 3, d8 = (tid & 7) * 8;
          const uint4 u = *(const uint4*)(SA + (size_t)(rowbase + tk) * 1536 + 1024 + h * 64 + d8);
          bf16_t* tp = tile + tk * 66 + d8; ((unsigned*)tp)[0] = u.x; ((unsigned*)tp)[1] = u.y; ((unsigned*)tp)[2] = u.z; ((unsigned*)tp)[3] = u.w; }
        __syncthreads();
        { const int d = tid >> 3, k8 = (tid & 7) * 8;
          unsigned o[4];
#pragma unroll
          for (int e = 0; e < 4; ++e) o[e] = (unsigned)tile[(k8 + 2 * e) * 66 + d] | ((unsigned)tile[(k8 + 2 * e + 1) * 66 + d] << 16);
          *(uint4*)(dst + (size_t)d * tlen + k8) = make_uint4(o[0], o[1], o[2], o[3]); }
        __syncthreads();
    }
}

__device__ void attn_wave(const Params& p, const float* rpb_l  , bool is_ctx, int b, int h, int i, int g) {
    unsigned char* ws = lnd(p.ws);
    const bf16_t* SA = (const bf16_t*)(ws + OFF_SATTN);
    bf16_t* BR2 = (bf16_t*)(ws + OFF_BR + 2 * SZ_BR1);
    const bf16_t* VT = (const bf16_t*)(ws + OFF_VT) + ((size_t)(b * 8 + h) * 64) * 8192;
    const bf16_t* VTC = (const bf16_t*)(ws + OFF_VTC) + ((size_t)(b * 8 + h) * 64) * 256;
    const int lane = my_tid() & 63, ql = lane & 15, g4 = lane >> 4;
    const int koff = 8 * (ql >> 2) + (ql & 3);
    int rowq, qcol = 0;
    if (is_ctx) rowq = TL + b * 256 + g * 16 + ql; else { qcol = g * 16 + ql; rowq = b * 8192 + i * 64 + qcol; }
    bf16x8 qp[2], qr[2];
    qp[0] = *(const bf16x8*)(SA + (size_t)rowq * 1536 + h * 64 + g4 * 8); qp[1] = *(const bf16x8*)(SA + (size_t)rowq * 1536 + h * 64 + 32 + g4 * 8);
    float m_run = -1e30f, l_run = 0.f;
    f32x4 O[4];
#pragma unroll
    for (int mt = 0; mt < 4; ++mt) O[mt] = (f32x4){0.f, 0.f, 0.f, 0.f};
    const f32x4 zero4 = (f32x4){0.f, 0.f, 0.f, 0.f};
    if (!is_ctx) {
        qr[0] = *(const bf16x8*)(BR2 + (size_t)rowq * 512 + h * 64 + g4 * 8); qr[1] = *(const bf16x8*)(BR2 + (size_t)rowq * 512 + h * 64 + 32 + g4 * 8);
        const int row_start = min(max(i - 4, 0), 120), c0 = min(max(16 * g - 8, 0), 32), col_start = min(max(qcol - 8, 0), 48);
        const float* rb = rpb_l + h * 465;
        for (int r = 0; r < 8; ++r) {
            const int krow = row_start + r, t0 = krow * 64 + c0;
            const bf16_t* kp0 = SA + (size_t)(b * 8192 + t0 + koff) * 1536 + 512 + h * 64 + g4 * 8; const bf16_t* kp1 = kp0 + (size_t)4 * 1536;
            const bf16x8 k00 = *(const bf16x8*)kp0, k01 = *(const bf16x8*)(kp0 + 32), k10 = *(const bf16x8*)kp1, k11 = *(const bf16x8*)(kp1 + 32);
            bf16x8 vf[4];
#pragma unroll
            for (int mt = 0; mt < 4; ++mt) vf[mt] = *(const bf16x8*)(VT + (size_t)(mt * 16 + ql) * 8192 + t0 + 8 * g4);
            f32x4 s0 = __builtin_amdgcn_mfma_f32_16x16x32_bf16(k00, qr[0], zero4, 0, 0, 0); s0 = __builtin_amdgcn_mfma_f32_16x16x32_bf16(k01, qr[1], s0, 0, 0, 0);
            f32x4 s1 = __builtin_amdgcn_mfma_f32_16x16x32_bf16(k10, qr[0], zero4, 0, 0, 0); s1 = __builtin_amdgcn_mfma_f32_16x16x32_bf16(k11, qr[1], s1, 0, 0, 0);
            const float* rbr = rb + (krow - i + 7) * 31;
            float sc[8]; float mx = -1e30f;
#pragma unroll
            for (int e = 0; e < 8; ++e) {
                const int kc = c0 + 8 * g4 + e; const int dc = min(max(kc - qcol + 15, 0), 30);
                const float raw = e < 4 ? s0[e & 3] : s1[e & 3];
                const bool inw = kc >= col_start && kc < col_start + 16;
                sc[e] = inw ? raw * 0.125f + rbr[dc] : -1e30f; mx = fmaxf(mx, sc[e]);
            }
            mx = xrow16_max(mx);
            const float m_new = fmaxf(m_run, mx), alpha = __expf(m_run - m_new); m_run = m_new;
            float ps = 0.f;
#pragma unroll
            for (int e = 0; e < 8; ++e) { sc[e] = __expf(sc[e] - m_new); ps += sc[e]; }
            l_run = l_run * alpha + ps;
            bf16x8 pf; { const unsigned u0 = cvtpk(sc[0], sc[1]), u1 = cvtpk(sc[2], sc[3]), u2 = cvtpk(sc[4], sc[5]), u3 = cvtpk(sc[6], sc[7]);
                typedef unsigned u32x4 __attribute__((ext_vector_type(4))); const u32x4 uu = {u0, u1, u2, u3}; pf = __builtin_bit_cast(bf16x8, uu); }
#pragma unroll
            for (int mt = 0; mt < 4; ++mt) { O[mt] *= alpha; O[mt] = __builtin_amdgcn_mfma_f32_16x16x32_bf16(vf[mt], pf, O[mt], 0, 0, 0); }
        }
    }
    for (int sp = 0; sp < 8; ++sp) {
        const bf16_t* kp0 = SA + (size_t)(TL + b * 256 + sp * 32 + koff) * 1536 + 512 + h * 64 + g4 * 8; const bf16_t* kp1 = kp0 + (size_t)4 * 1536;
        const bf16x8 k00 = *(const bf16x8*)kp0, k01 = *(const bf16x8*)(kp0 + 32), k10 = *(const bf16x8*)kp1, k11 = *(const bf16x8*)(kp1 + 32);
        bf16x8 vf[4];
#pragma unroll
        for (int mt = 0; mt < 4; ++mt) vf[mt] = *(const bf16x8*)(VTC + (size_t)(mt * 16 + ql) * 256 + sp * 32 + 8 * g4);
        f32x4 s0 = __builtin_amdgcn_mfma_f32_16x16x32_bf16(k00, qp[0], zero4, 0, 0, 0); s0 = __builtin_amdgcn_mfma_f32_16x16x32_bf16(k01, qp[1], s0, 0, 0, 0);
        f32x4 s1 = __builtin_amdgcn_mfma_f32_16x16x32_bf16(k10, qp[0], zero4, 0, 0, 0); s1 = __builtin_amdgcn_mfma_f32_16x16x32_bf16(k11, qp[1], s1, 0, 0, 0);
        float sc[8]; float mx = -1e30f;
#pragma unroll
        for (int e = 0; e < 8; ++e) { sc[e] = (e < 4 ? s0[e & 3] : s1[e & 3]) * 0.125f; mx = fmaxf(mx, sc[e]); }
        mx = xrow16_max(mx);
        const float m_new = fmaxf(m_run, mx), alpha = __expf(m_run - m_new); m_run = m_new;
        float ps = 0.f;
#pragma unroll
        for (int e = 0; e < 8; ++e) { sc[e] = __expf(sc[e] - m_new); ps += sc[e]; }
        l_run = l_run * alpha + ps;
        bf16x8 pf; { const unsigned u0 = cvtpk(sc[0], sc[1]), u1 = cvtpk(sc[2], sc[3]), u2 = cvtpk(sc[4], sc[5]), u3 = cvtpk(sc[6], sc[7]);
            typedef unsigned u32x4 __attribute__((ext_vector_type(4))); const u32x4 uu = {u0, u1, u2, u3}; pf = __builtin_bit_cast(bf16x8, uu); }
#pragma unroll
        for (int mt = 0; mt < 4; ++mt) { O[mt] *= alpha; O[mt] = __builtin_amdgcn_mfma_f32_16x16x32_bf16(vf[mt], pf, O[mt], 0, 0, 0); }
    }
    const float inv = 1.f / xrow16_sum(l_run);
#pragma unroll
    for (int mt = 0; mt < 4; ++mt) st4bf(BR2 + (size_t)rowq * 512 + h * 64 + mt * 16 + 4 * g4, O[mt] * inv);
}

__device__ void phase_attn(const Params& p, int l, float* lds, int ab, int nab) {
    const int tid = my_tid(), w = tid >> 6;
    const float* rpb = lnd(p.in[I_RPB]) + (size_t)l * 8 * 465;
    for (int e = tid; e < 8 * 465; e += 512) lds[e] = rpb[e];
    __syncthreads();
    const int nlat = 8 * 128 * 4, nall = nlat + (l == 0 ? 128 : 0);
    for (int u = ab; u < nall; u += nab) {
        if (u < nlat) { const int b = u >> 9, i = (u >> 2) & 127, hp = u & 3; attn_wave(p, lds, false, b, 2 * hp + (w >> 2), i, w & 3); }
        else { const int j = u - nlat; const int b = j >> 4, hp = (j >> 2) & 3, qq = j & 3; attn_wave(p, lds, true, b, 2 * hp + (w >> 2), 0, 4 * qq + (w & 3)); }
    }
    __syncthreads();
}

constexpr int CH = 32;
__device__ void scan_head(const Params& p, int l, int hd, float* lds) {
    unsigned char* ws = lnd(p.ws);
    const bf16_t* SR = (const bf16_t*)(ws + OFF_SRKV);
    const bf16_t* SL = (const bf16_t*)(ws + OFF_SLORA);
    const int tid = my_tid();
    const int d = hd >> 6, b = (hd >> 3) & 7, h = hd & 7;
    bf16_t* BON = (bf16_t*)(ws + OFF_BON) + (size_t)d * TT * 512;
    bf16_t* YO = (bf16_t*)(ws + OFF_Y) + (size_t)d * TT * 512;
    float* w2s = lds; float* a2s = w2s + 4096;
    float* cR = a2s + 4096; float* cW = cR + CH * 64; float* cK = cW + CH * 64; float* cV = cK + CH * 64; float* cA = cV + CH * 64; float* cB = cA + CH * 64;
    float* tl = cB + CH * 64; float* lam = tl + CH * 64; float* Yl = lam + CH * 64; float* hp = Yl + CH * 64;
    __syncthreads();
    {
        const float* w2 = lnd(p.in[I_W2]) + (size_t)(l * 2 + d) * 64 * 512 + h * 64; const float* a2 = lnd(p.in[I_A2]) + (size_t)(l * 2 + d) * 64 * 512 + h * 64;
        for (int e = tid; e < 4096; e += 512) { const int j = e >> 6, i = e & 63; w2s[e] = w2[j * 512 + i]; a2s[e] = a2[j * 512 + i]; }
        if (tid < 64) {
            const float* mu = lnd(p.in[I_MU]) + (size_t)(l * 2 + d) * 1664;
            hp[0 * 64 + tid] = lnd(p.in[I_W0])[(l * 2 + d) * 512 + h * 64 + tid];
            hp[1 * 64 + tid] = lnd(p.in[I_A0])[(l * 2 + d) * 512 + h * 64 + tid];
            hp[2 * 64 + tid] = lnd(p.in[I_KK])[l * 512 + h * 64 + tid];
            hp[3 * 64 + tid] = lnd(p.in[I_KA])[l * 512 + h * 64 + tid];
            hp[4 * 64 + tid] = lnd(p.in[I_RK])[(l * 8 + h) * 64 + tid];
            hp[5 * 64 + tid] = mu[h * 64 + tid];
            hp[6 * 64 + tid] = mu[512 + h * 64 + tid];
            hp[7 * 64 + tid] = mu[1024 + h * 64 + tid];
            hp[8 * 64 + tid] = mu[1536 + tid];
            hp[9 * 64 + tid] = mu[1600 + tid];
        }
    }
    __syncthreads();
    float S[8];
#pragma unroll
    for (int e = 0; e < 8; ++e) S[e] = 0.f;
    const int irow = tid >> 3, js = tid & 7;
    const int slp = tid >> 4, c4 = tid & 15;
    for (int chunk = 0; chunk < (CTXL + SEQ) / CH; ++chunk) {
        const int s = chunk * CH + slp;
        int row, nrow; bool nv;
        if (s < CTXL) { const int li = d ? (CTXL - 1 - s) : s; row = TL + b * CTXL + li; nv = d ? (li < CTXL - 1) : (li > 0); }
        else { const int t = d ? (SEQ - 1 - (s - CTXL)) : (s - CTXL); row = b * SEQ + t; nv = d ? (t < SEQ - 1) : (t > 0); }
        nrow = d ? row + 1 : row - 1;
        float rm[4], km[4], vm[4];
        {
            const uint2 z2 = make_uint2(0u, 0u);
            const uint2 lw = *(const uint2*)(SL + (size_t)row * 256 + 4 * c4), la = *(const uint2*)(SL + (size_t)row * 256 + 64 + 4 * c4);
            const uint2 lwn = nv ? *(const uint2*)(SL + (size_t)nrow * 256 + 4 * c4) : z2, lan = nv ? *(const uint2*)(SL + (size_t)nrow * 256 + 64 + 4 * c4) : z2;
            const float x[4] = {bflo(lw.x), bfhi(lw.x), bflo(lw.y), bfhi(lw.y)}, xn[4] = {bflo(lwn.x), bfhi(lwn.x), bflo(lwn.y), bfhi(lwn.y)};
            const float y[4] = {bflo(la.x), bfhi(la.x), bflo(la.y), bfhi(la.y)}, yn[4] = {bflo(lan.x), bfhi(lan.x), bflo(lan.y), bfhi(lan.y)};
#pragma unroll
            for (int e = 0; e < 4; ++e) { tl[slp * 64 + 4 * c4 + e] = tanh_fast(x[e] + hp[8 * 64 + 4 * c4 + e] * (xn[e] - x[e])); lam[slp * 64 + 4 * c4 + e] = y[e] + hp[9 * 64 + 4 * c4 + e] * (yn[e] - y[e]); }
            const bf16_t* pr = SR + (size_t)row * 1536 + h * 64 + 4 * c4; const bf16_t* pn = SR + (size_t)nrow * 1536 + h * 64 + 4 * c4;
            const uint2 r0 = *(const uint2*)pr, k0 = *(const uint2*)(pr + 512), v0 = *(const uint2*)(pr + 1024);
            const uint2 r1 = nv ? *(const uint2*)pn : z2, k1 = nv ? *(const uint2*)(pn + 512) : z2, v1 = nv ? *(const uint2*)(pn + 1024) : z2;
            const float ra[4] = {bflo(r0.x), bfhi(r0.x), bflo(r0.y), bfhi(r0.y)}, rb[4] = {bflo(r1.x), bfhi(r1.x), bflo(r1.y), bfhi(r1.y)};
            const float ka[4] = {bflo(k0.x), bfhi(k0.x), bflo(k0.y), bfhi(k0.y)}, kb[4] = {bflo(k1.x), bfhi(k1.x), bflo(k1.y), bfhi(k1.y)};
            const float va[4] = {bflo(v0.x), bfhi(v0.x), bflo(v0.y), bfhi(v0.y)}, vb[4] = {bflo(v1.x), bfhi(v1.x), bflo(v1.y), bfhi(v1.y)};
#pragma unroll
            for (int e = 0; e < 4; ++e) { const int i = 4 * c4 + e;
                rm[e] = ra[e] + hp[5 * 64 + i] * (rb[e] - ra[e]); km[e] = ka[e] + hp[6 * 64 + i] * (kb[e] - ka[e]); vm[e] = va[e] + hp[7 * 64 + i] * (vb[e] - va[e]); }
        }
        __syncthreads();
        {
            float wl[4], al[4];
#pragma unroll
            for (int e = 0; e < 4; ++e) { wl[e] = hp[0 * 64 + 4 * c4 + e]; al[e] = hp[1 * 64 + 4 * c4 + e]; }
            for (int j4 = 0; j4 < 16; ++j4) {
                const float4 tv = *(const float4*)(tl + slp * 64 + 4 * j4), lv = *(const float4*)(lam + slp * 64 + 4 * j4);
                const float tj[4] = {tv.x, tv.y, tv.z, tv.w}, lj[4] = {lv.x, lv.y, lv.z, lv.w};
#pragma unroll
                for (int jj = 0; jj < 4; ++jj) { const float4 wv = *(const float4*)(w2s + (4 * j4 + jj) * 64 + 4 * c4), av = *(const float4*)(a2s + (4 * j4 + jj) * 64 + 4 * c4);
                    wl[0] += tj[jj] * wv.x; wl[1] += tj[jj] * wv.y; wl[2] += tj[jj] * wv.z; wl[3] += tj[jj] * wv.w;
                    al[0] += lj[jj] * av.x; al[1] += lj[jj] * av.y; al[2] += lj[jj] * av.z; al[3] += lj[jj] * av.w; }
            }
            float kk[4], ss = 0.f, rk = 0.f, ag[4], kmod[4];
#pragma unroll
            for (int e = 0; e < 4; ++e) { const int i = 4 * c4 + e;
                const float x = -wl[e]; const float sp = fmaxf(x, 0.f) + __logf(1.f + __expf(-fabsf(x)));
                const float wlog = -sp - 0.5f; cW[slp * 64 + i] = __expf(-__expf(wlog));
                ag[e] = sigmoidf_(al[e]);
                kk[e] = km[e] * hp[2 * 64 + i]; ss += kk[e] * kk[e];
                kmod[e] = km[e] * (1.f + (ag[e] - 1.f) * hp[3 * 64 + i]);
                rk += rm[e] * kmod[e] * hp[4 * 64 + i]; }
            ss = sum16(ss); rk = sum16(rk);
            const float rn = rsqrtf(fmaxf(ss, 1e-24f));
            float bo[4];
#pragma unroll
            for (int e = 0; e < 4; ++e) { const int i = 4 * c4 + e; kk[e] *= rn;
                cR[slp * 64 + i] = rm[e]; cK[slp * 64 + i] = kmod[e]; cV[slp * 64 + i] = vm[e]; cA[slp * 64 + i] = -kk[e]; cB[slp * 64 + i] = kk[e] * ag[e]; bo[e] = rk * vm[e]; }
            *(uint2*)(BON + (size_t)row * 512 + h * 64 + 4 * c4) = make_uint2(cvtpk(bo[0], bo[1]), cvtpk(bo[2], bo[3]));
        }
        __syncthreads();
        for (int sl = 0; sl < CH; ++sl) {
            const float4 a0 = *(const float4*)(cA + sl * 64 + 8 * js), a1 = *(const float4*)(cA + sl * 64 + 8 * js + 4);
            const float4 w0 = *(const float4*)(cW + sl * 64 + 8 * js), w1 = *(const float4*)(cW + sl * 64 + 8 * js + 4);
            const float4 k0 = *(const float4*)(cK + sl * 64 + 8 * js), k1 = *(const float4*)(cK + sl * 64 + 8 * js + 4);
            const float4 b0 = *(const float4*)(cB + sl * 64 + 8 * js), b1 = *(const float4*)(cB + sl * 64 + 8 * js + 4);
            const float4 r0 = *(const float4*)(cR + sl * 64 + 8 * js), r1 = *(const float4*)(cR + sl * 64 + 8 * js + 4);
            const float vv = cV[sl * 64 + irow];
            float sa = S[0] * a0.x + S[1] * a0.y + S[2] * a0.z + S[3] * a0.w + S[4] * a1.x + S[5] * a1.y + S[6] * a1.z + S[7] * a1.w;
            sa = sum8(sa);
            S[0] = S[0] * w0.x + (vv * k0.x + sa * b0.x); S[1] = S[1] * w0.y + (vv * k0.y + sa * b0.y); S[2] = S[2] * w0.z + (vv * k0.z + sa * b0.z); S[3] = S[3] * w0.w + (vv * k0.w + sa * b0.w);
            S[4] = S[4] * w1.x + (vv * k1.x + sa * b1.x); S[5] = S[5] * w1.y + (vv * k1.y + sa * b1.y); S[6] = S[6] * w1.z + (vv * k1.z + sa * b1.z); S[7] = S[7] * w1.w + (vv * k1.w + sa * b1.w);
            float y = S[0] * r0.x + S[1] * r0.y + S[2] * r0.z + S[3] * r0.w + S[4] * r1.x + S[5] * r1.y + S[6] * r1.z + S[7] * r1.w;
            y = sum8(y);
            if (js == 0) Yl[sl * 64 + irow] = y;
        }
        __syncthreads();
        { const float4 yv = *(const float4*)(Yl + slp * 64 + 4 * c4);
          *(uint2*)(YO + (size_t)row * 512 + h * 64 + 4 * c4) = make_uint2(cvtpk(yv.x, yv.y), cvtpk(yv.z, yv.w)); }
    }
    __syncthreads();
}


typedef float f32x2 __attribute__((ext_vector_type(2)));
struct StepOps { f32x2 a[4], w[4], k[4], b[4], r[4]; float v0, v1; };
__device__ __forceinline__ void ld_step(StepOps& X, const float* buf, int sl, int js, int i0) {
    const float* q = buf + sl * 64 + 8 * js;
    const float4 r0 = *(const float4*)(q), r1 = *(const float4*)(q + 4);
    const float4 w0 = *(const float4*)(q + 2048), w1 = *(const float4*)(q + 2048 + 4);
    const float4 k0 = *(const float4*)(q + 4096), k1 = *(const float4*)(q + 4096 + 4);
    const float4 a0 = *(const float4*)(q + 8192), a1 = *(const float4*)(q + 8192 + 4);
    const float4 b0 = *(const float4*)(q + 10240), b1 = *(const float4*)(q + 10240 + 4);
    X.r[0] = (f32x2){r0.x, r0.y}; X.r[1] = (f32x2){r0.z, r0.w}; X.r[2] = (f32x2){r1.x, r1.y}; X.r[3] = (f32x2){r1.z, r1.w};
    X.w[0] = (f32x2){w0.x, w0.y}; X.w[1] = (f32x2){w0.z, w0.w}; X.w[2] = (f32x2){w1.x, w1.y}; X.w[3] = (f32x2){w1.z, w1.w};
    X.k[0] = (f32x2){k0.x, k0.y}; X.k[1] = (f32x2){k0.z, k0.w}; X.k[2] = (f32x2){k1.x, k1.y}; X.k[3] = (f32x2){k1.z, k1.w};
    X.a[0] = (f32x2){a0.x, a0.y}; X.a[1] = (f32x2){a0.z, a0.w}; X.a[2] = (f32x2){a1.x, a1.y}; X.a[3] = (f32x2){a1.z, a1.w};
    X.b[0] = (f32x2){b0.x, b0.y}; X.b[1] = (f32x2){b0.z, b0.w}; X.b[2] = (f32x2){b1.x, b1.y}; X.b[3] = (f32x2){b1.z, b1.w};
    X.v0 = buf[6144 + sl * 64 + i0]; X.v1 = buf[6144 + sl * 64 + i0 + 32];
}
__device__ __forceinline__ void do_step(const StepOps& X, f32x2 (&S0)[4], f32x2 (&S1)[4], float* yl, int sl, int js, int i0) {
    f32x2 t0 = S0[0] * X.a[0], t1 = S1[0] * X.a[0];
#pragma unroll
    for (int e = 1; e < 4; ++e) { t0 = S0[e] * X.a[e] + t0; t1 = S1[e] * X.a[e] + t1; }
    const float sa0 = sum8(t0.x + t0.y), sa1 = sum8(t1.x + t1.y);
#pragma unroll
    for (int e = 0; e < 4; ++e) {
        const f32x2 u0 = X.b[e] * sa0 + X.k[e] * X.v0, u1 = X.b[e] * sa1 + X.k[e] * X.v1;
        S0[e] = S0[e] * X.w[e] + u0; S1[e] = S1[e] * X.w[e] + u1;
    }
    f32x2 y0 = S0[0] * X.r[0], y1 = S1[0] * X.r[0];
#pragma unroll
    for (int e = 1; e < 4; ++e) { y0 = S0[e] * X.r[e] + y0; y1 = S1[e] * X.r[e] + y1; }
    const float ys0 = sum8(y0.x + y0.y), ys1 = sum8(y1.x + y1.y);
    if (js == 0) { yl[sl * 64 + i0] = ys0; yl[sl * 64 + i0 + 32] = ys1; }
}
__device__ __forceinline__ void step_row(int d, int b, int s, int& row, int& nrow, bool& nv) {
    if (s < CTXL) { const int li = d ? (CTXL - 1 - s) : s; row = TL + b * CTXL + li; nv = d ? (li < CTXL - 1) : (li > 0); }
    else { const int t = d ? (SEQ - 1 - (s - CTXL)) : (s - CTXL); row = b * SEQ + t; nv = d ? (t < SEQ - 1) : (t > 0); }
    nrow = d ? row + 1 : row - 1;
}
__device__ __forceinline__ void mix8(const uint4 z, const uint4 zn, const float* mu, float* o) {
    float a[8], bb[8]; unpack8(z, a); unpack8(zn, bb);
#pragma unroll
    for (int e = 0; e < 8; ++e) o[e] = a[e] + mu[e] * (bb[e] - a[e]);
}

__device__ void scan_head2(const Params& p, int l, int hd, unsigned char* smem) {
    unsigned char* ws = lnd(p.ws);
    const bf16_t* SR = (const bf16_t*)(ws + OFF_SRKV);
    const bf16_t* SL = (const bf16_t*)(ws + OFF_SLORA);
    const int tid = my_tid();
    const int wv = __builtin_amdgcn_readfirstlane(tid >> 6), lane = tid & 63;
    const int d = hd >> 6, b = (hd >> 3) & 7, h = hd & 7;
    bf16_t* BON = (bf16_t*)(ws + OFF_BON) + (size_t)d * TT * 512;
    bf16_t* YO = (bf16_t*)(ws + OFF_Y) + (size_t)d * TT * 512;
    float* bufs = (float*)smem;
    float* yls = bufs + 2 * 12288;
    unsigned char* pscr = smem + 114688;
    float* hp = (float*)(smem + 139264);
    constexpr int NCH = (CTXL + SEQ) / 32;
    __syncthreads();
    if (tid < 64) {
        const float* mu = lnd(p.in[I_MU]) + (size_t)(l * 2 + d) * 1664;
        hp[0 * 64 + tid] = lnd(p.in[I_W0])[(l * 2 + d) * 512 + h * 64 + tid];
        hp[1 * 64 + tid] = lnd(p.in[I_A0])[(l * 2 + d) * 512 + h * 64 + tid];
        hp[2 * 64 + tid] = lnd(p.in[I_KK])[l * 512 + h * 64 + tid];
        hp[3 * 64 + tid] = lnd(p.in[I_KA])[l * 512 + h * 64 + tid];
        hp[4 * 64 + tid] = lnd(p.in[I_RK])[(l * 8 + h) * 64 + tid];
        hp[5 * 64 + tid] = mu[h * 64 + tid];
        hp[6 * 64 + tid] = mu[512 + h * 64 + tid];
        hp[7 * 64 + tid] = mu[1024 + h * 64 + tid];
        hp[8 * 64 + tid] = mu[1536 + tid];
        hp[9 * 64 + tid] = mu[1600 + tid];
    }
    __syncthreads();
    if (wv < 4) {
        const int js = lane & 7, i0 = wv * 8 + (lane >> 3);
        f32x2 S0[4], S1[4];
#pragma unroll
        for (int e = 0; e < 4; ++e) { S0[e] = (f32x2){0.f, 0.f}; S1[e] = (f32x2){0.f, 0.f}; }
        __syncthreads();
        for (int c = 0; c < NCH; ++c) {
            const float* buf = bufs + (c & 1) * 12288; float* yl = yls + (c & 1) * 2048;
            StepOps A0, A1;
            ld_step(A0, buf, 0, js, i0);
            for (int sl = 0; sl < 32; sl += 2) {
                ld_step(A1, buf, sl + 1, js, i0);
                do_step(A0, S0, S1, yl, sl, js, i0);
                ld_step(A0, buf, min(sl + 2, 31), js, i0);
                do_step(A1, S0, S1, yl, sl + 1, js, i0);
            }
            __syncthreads();
        }
    } else {
        const int pw = wv - 4, s8 = lane >> 3, c8 = lane & 7, ql = lane & 15, g4 = lane >> 4;
        bf16_t* tlb = (bf16_t*)(pscr + pw * 6144); bf16_t* lmb = tlb + 512; float* wlf = (float*)(tlb + 1024); float* alf = wlf + 512;
        bf16x8 bw[4][2], ba[4][2];
        {
            const float* w2 = lnd(p.in[I_W2]) + (size_t)(l * 2 + d) * 64 * 512 + h * 64; const float* a2 = lnd(p.in[I_A2]) + (size_t)(l * 2 + d) * 64 * 512 + h * 64;
#pragma unroll
            for (int nt = 0; nt < 4; ++nt)
#pragma unroll
                for (int ks = 0; ks < 2; ++ks) {
                    float fw[8], fa[8];
#pragma unroll
                    for (int jj = 0; jj < 8; ++jj) { const int j = ks * 32 + 8 * g4 + jj; fw[jj] = w2[j * 512 + nt * 16 + ql]; fa[jj] = a2[j * 512 + nt * 16 + ql]; }
                    const uint4 uw = pack8(fw), ua = pack8(fa);
                    bw[nt][ks] = __builtin_bit_cast(bf16x8, uw); ba[nt][ks] = __builtin_bit_cast(bf16x8, ua);
                }
        }
        const f32x4 zero4 = (f32x4){0.f, 0.f, 0.f, 0.f};
        for (int c = -1; c < NCH; ++c) {
            if (c > 0) {
                int row, nrow; bool nv; step_row(d, b, (c - 1) * 32 + 8 * pw + s8, row, nrow, nv);
                const float* yl = yls + ((c - 1) & 1) * 2048 + (8 * pw + s8) * 64 + 8 * c8;
                const float4 y0 = *(const float4*)yl, y1 = *(const float4*)(yl + 4);
                *(uint4*)(YO + (size_t)row * 512 + h * 64 + 8 * c8) = make_uint4(cvtpk(y0.x, y0.y), cvtpk(y0.z, y0.w), cvtpk(y1.x, y1.y), cvtpk(y1.z, y1.w));
            }
            if (c + 1 < NCH) {
                float* buf = bufs + ((c + 1) & 1) * 12288;
                int row, nrow; bool nv; step_row(d, b, (c + 1) * 32 + 8 * pw + s8, row, nrow, nv);
                const uint4 z4 = make_uint4(0u, 0u, 0u, 0u);
                float rm[8], km[8], vm[8];
                {
                    const bf16_t* pl = SL + (size_t)row * 256 + 8 * c8; const bf16_t* pln = SL + (size_t)nrow * 256 + 8 * c8;
                    const uint4 lw = *(const uint4*)pl, la = *(const uint4*)(pl + 64);
                    const uint4 lwn = nv ? *(const uint4*)pln : z4, lan = nv ? *(const uint4*)(pln + 64) : z4;
                    const bf16_t* pr = SR + (size_t)row * 1536 + h * 64 + 8 * c8; const bf16_t* pn = SR + (size_t)nrow * 1536 + h * 64 + 8 * c8;
                    const uint4 r0 = *(const uint4*)pr, k0 = *(const uint4*)(pr + 512), v0 = *(const uint4*)(pr + 1024);
                    const uint4 r1 = nv ? *(const uint4*)pn : z4, k1 = nv ? *(const uint4*)(pn + 512) : z4, v1 = nv ? *(const uint4*)(pn + 1024) : z4;
                    float lwm[8], lam8[8];
                    mix8(lw, lwn, hp + 8 * 64 + 8 * c8, lwm); mix8(la, lan, hp + 9 * 64 + 8 * c8, lam8);
#pragma unroll
                    for (int e = 0; e < 8; ++e) lwm[e] = tanh_fast(lwm[e]);
                    *(uint4*)(tlb + s8 * 64 + 8 * c8) = pack8(lwm); *(uint4*)(lmb + s8 * 64 + 8 * c8) = pack8(lam8);
                    mix8(r0, r1, hp + 5 * 64 + 8 * c8, rm); mix8(k0, k1, hp + 6 * 64 + 8 * c8, km); mix8(v0, v1, hp + 7 * 64 + 8 * c8, vm);
                }
                asm volatile("s_waitcnt lgkmcnt(0)" ::: "memory");
                {
                    const bf16x8 aw0 = *(const bf16x8*)(tlb + (ql & 7) * 64 + 8 * g4), aw1 = *(const bf16x8*)(tlb + (ql & 7) * 64 + 32 + 8 * g4);
                    const bf16x8 aa0 = *(const bf16x8*)(lmb + (ql & 7) * 64 + 8 * g4), aa1 = *(const bf16x8*)(lmb + (ql & 7) * 64 + 32 + 8 * g4);
#pragma unroll
                    for (int nt = 0; nt < 4; ++nt) {
                        f32x4 cw = __builtin_amdgcn_mfma_f32_16x16x32_bf16(aw0, bw[nt][0], zero4, 0, 0, 0); cw = __builtin_amdgcn_mfma_f32_16x16x32_bf16(aw1, bw[nt][1], cw, 0, 0, 0);
                        f32x4 ca = __builtin_amdgcn_mfma_f32_16x16x32_bf16(aa0, ba[nt][0], zero4, 0, 0, 0); ca = __builtin_amdgcn_mfma_f32_16x16x32_bf16(aa1, ba[nt][1], ca, 0, 0, 0);
                        if (g4 < 2) {
#pragma unroll
                            for (int v = 0; v < 4; ++v) { wlf[(4 * g4 + v) * 64 + nt * 16 + ql] = cw[v]; alf[(4 * g4 + v) * 64 + nt * 16 + ql] = ca[v]; }
                        }
                    }
                }
                asm volatile("s_waitcnt lgkmcnt(0)" ::: "memory");
                {
                    float wl[8], al[8];
                    { const float4 x0 = *(const float4*)(wlf + s8 * 64 + 8 * c8), x1 = *(const float4*)(wlf + s8 * 64 + 8 * c8 + 4), y0 = *(const float4*)(alf + s8 * 64 + 8 * c8), y1 = *(const float4*)(alf + s8 * 64 + 8 * c8 + 4);
                      wl[0] = x0.x; wl[1] = x0.y; wl[2] = x0.z; wl[3] = x0.w; wl[4] = x1.x; wl[5] = x1.y; wl[6] = x1.z; wl[7] = x1.w;
                      al[0] = y0.x; al[1] = y0.y; al[2] = y0.z; al[3] = y0.w; al[4] = y1.x; al[5] = y1.y; al[6] = y1.z; al[7] = y1.w; }
                    float dec[8], ag[8], kk[8], kmod[8], ss = 0.f, rk = 0.f;
#pragma unroll
                    for (int e = 0; e < 8; ++e) { const int i = 8 * c8 + e;
                        const float x = -(wl[e] + hp[i]); const float sp = fmaxf(x, 0.f) + __logf(1.f + __expf(-fabsf(x)));
                        dec[e] = __expf(-__expf(-sp - 0.5f));
                        ag[e] = sigmoidf_(al[e] + hp[64 + i]);
                        kk[e] = km[e] * hp[2 * 64 + i]; ss += kk[e] * kk[e];
                        kmod[e] = km[e] * (1.f + (ag[e] - 1.f) * hp[3 * 64 + i]);
                        rk += rm[e] * kmod[e] * hp[4 * 64 + i]; }
                    ss = sum8(ss); rk = sum8(rk);
                    const float rn = rsqrtf(fmaxf(ss, 1e-24f));
                    float av[8], bv[8], bo[8];
#pragma unroll
                    for (int e = 0; e < 8; ++e) { kk[e] *= rn; av[e] = -kk[e]; bv[e] = kk[e] * ag[e]; bo[e] = rk * vm[e]; }
                    float* q = buf + (8 * pw + s8) * 64 + 8 * c8;
                    *(float4*)(q) = make_float4(rm[0], rm[1], rm[2], rm[3]); *(float4*)(q + 4) = make_float4(rm[4], rm[5], rm[6], rm[7]);
                    *(float4*)(q + 2048) = make_float4(dec[0], dec[1], dec[2], dec[3]); *(float4*)(q + 2048 + 4) = make_float4(dec[4], dec[5], dec[6], dec[7]);
                    *(float4*)(q + 4096) = make_float4(kmod[0], kmod[1], kmod[2], kmod[3]); *(float4*)(q + 4096 + 4) = make_float4(kmod[4], kmod[5], kmod[6], kmod[7]);
                    *(float4*)(q + 6144) = make_float4(vm[0], vm[1], vm[2], vm[3]); *(float4*)(q + 6144 + 4) = make_float4(vm[4], vm[5], vm[6], vm[7]);
                    *(float4*)(q + 8192) = make_float4(av[0], av[1], av[2], av[3]); *(float4*)(q + 8192 + 4) = make_float4(av[4], av[5], av[6], av[7]);
                    *(float4*)(q + 10240) = make_float4(bv[0], bv[1], bv[2], bv[3]); *(float4*)(q + 10240 + 4) = make_float4(bv[4], bv[5], bv[6], bv[7]);
                    *(uint4*)(BON + (size_t)row * 512 + h * 64 + 8 * c8) = pack8(bo);
                }
            }
            __syncthreads();
        }
        {
            int row, nrow; bool nv; step_row(d, b, (NCH - 1) * 32 + 8 * pw + s8, row, nrow, nv);
            const float* yl = yls + ((NCH - 1) & 1) * 2048 + (8 * pw + s8) * 64 + 8 * c8;
            const float4 y0 = *(const float4*)yl, y1 = *(const float4*)(yl + 4);
            *(uint4*)(YO + (size_t)row * 512 + h * 64 + 8 * c8) = make_uint4(cvtpk(y0.x, y0.y), cvtpk(y0.z, y0.w), cvtpk(y1.x, y1.y), cvtpk(y1.z, y1.w));
        }
    }
    __syncthreads();
}

__device__ void phase_readout(const Params& p, int l) {
    unsigned char* ws = lnd(p.ws);
    const bf16_t* Y0 = (const bf16_t*)(ws + OFF_Y); const bf16_t* Y1 = Y0 + (size_t)TT * 512;
    const bf16_t* B0 = (const bf16_t*)(ws + OFF_BON); const bf16_t* B1 = B0 + (size_t)TT * 512;
    bf16_t* BR1 = (bf16_t*)(ws + OFF_BR + SZ_BR1);
    const float* lg = lnd(p.in[I_LNXG]) + l * 512; const float* lb = lnd(p.in[I_LNXB]) + l * 512;
    const size_t gt = (size_t)my_bid() * 512 + my_tid(), gn = (size_t)my_nb() * 512;
    for (size_t idx = gt; idx < (size_t)TT * 128; idx += gn) {
        const size_t off = idx * 4; const int c = (int)(off & 511);
        const uint2 ya = *(const uint2*)(Y0 + off), yb = *(const uint2*)(Y1 + off), ba = *(const uint2*)(B0 + off), bb = *(const uint2*)(B1 + off), gg = *(const uint2*)(BR1 + off);
        float y[4] = {bflo(ya.x) + bflo(yb.x), bfhi(ya.x) + bfhi(yb.x), bflo(ya.y) + bflo(yb.y), bfhi(ya.y) + bfhi(yb.y)};
        const float bon[4] = {bflo(ba.x) + bflo(bb.x), bfhi(ba.x) + bfhi(bb.x), bflo(ba.y) + bflo(bb.y), bfhi(ba.y) + bfhi(bb.y)};
        const float gt4[4] = {bflo(gg.x), bfhi(gg.x), bflo(gg.y), bfhi(gg.y)};
        const float mean = sum16(y[0] + y[1] + y[2] + y[3]) * (1.f / 64.f);
        float vs = 0.f;
#pragma unroll
        for (int e = 0; e < 4; ++e) { y[e] -= mean; vs += y[e] * y[e]; }
        const float rs = rsqrtf(sum16(vs) * (1.f / 64.f) + 64e-5f);
        float o[4];
#pragma unroll
        for (int e = 0; e < 4; ++e) o[e] = (y[e] * rs * lg[c + e] + lb[c + e] + bon[e]) * gt4[e];
        *(uint2*)(BR1 + off) = make_uint2(cvtpk(o[0], o[1]), cvtpk(o[2], o[3]));
    }
}

constexpr int NPH_LAYER = 12, NPHASE = 2 + NLAYER * NPH_LAYER;

__device__ void run_phase(const Params& p, int ph, unsigned char* smem) {
    unsigned char* ws = lnd(p.ws);
    float* lds = (float*)smem;
    const float* mod0 = (const float*)(ws + OFF_MOD);
    if (ph == 0) { prologue_mods(p, lds); __syncthreads(); convert_weights(p, 0, lds); return; }
    if (ph == 1) { rowwise(p, lnd(p.in[I_X]), lnd(p.in[I_CTX]), nullptr, nullptr, nullptr, nullptr, nullptr, 0, (bf16_t*)(ws + OFF_HX), lnd(p.in[I_NORMG]) + 0, mod0, 0, 1); return; }
    const int l = (ph - 2) / NPH_LAYER, st = (ph - 2) % NPH_LAYER;
    const float* modl = mod0 + (size_t)l * 9 * 6144;
    const float* ng = lnd(p.in[I_NORMG]) + (size_t)l * 4 * 1024;
    const float* xs_lat = l == 0 ? lnd(p.in[I_X]) : lnd(p.out); const float* xs_ctx = l == 0 ? lnd(p.in[I_CTX]) : (const float*)(ws + OFF_CTXRES);
    float* ctxres = (float*)(ws + OFF_CTXRES);
    const int G = my_nb(), c = my_bid();
    switch (st) {
    case 0: run_gemm(smem, (const bf16_t*)(ws + OFF_HX), 1024, (const bf16_t*)(ws + OFF_BTIN), NPROJ, 1024, 1 << 20, 0, FProj{ws}, G, c); break;
    case 1: phase_elem(p, l); break;
    case 2: phase_vt(p, lds); break;
    case 3: {
        const int nscan = G >= 192 ? 128 : G / 2;
        if (c < nscan) { for (int hd = c; hd < 128; hd += nscan) scan_head2(p, l, hd, smem); }
        else { phase_attn(p, l, lds, c - nscan, G - nscan);
               run_gemm(smem, (const bf16_t*)(ws + OFF_SLORA), 256, (const bf16_t*)(ws + OFF_BTG2), 512, 256, 1 << 20, 0, FPlain{(bf16_t*)(ws + OFF_BR + SZ_BR1), 512}, G - nscan, c - nscan); }
        break; }
    case 4: phase_readout(p, l);
            rowwise(p, xs_lat, xs_ctx, nullptr, nullptr, nullptr, nullptr, nullptr, 0, (bf16_t*)(ws + OFF_HXB), ng, modl, 0, 1); break;
    case 5: run_gemm(smem, (const bf16_t*)(ws + OFF_HXB), 1024, (const bf16_t*)(ws + OFF_BTIN) + (size_t)NPROJ * 1024, 3072, 1024, 1 << 20, 0, FSig{(bf16_t*)(ws + OFF_G), 3072}, G, c); break;
    case 6: run_gemm(smem, (const bf16_t*)(ws + OFF_BR), 512, (const bf16_t*)(ws + OFF_BTUP), 3072, 512, 4, SZ_BR1, FMulG{(bf16_t*)(ws + OFF_G), 3072}, G, c); break;
    case 7: run_gemm(smem, (const bf16_t*)(ws + OFF_G), 3072, (const bf16_t*)(ws + OFF_BTO3), 1024, 3072, 1 << 20, 0, FPlain{(bf16_t*)(ws + OFF_HX), 1024}, G, c); break;
    case 8: rowwise(p, xs_lat, xs_ctx, lnd(p.out), ctxres, (const bf16_t*)(ws + OFF_HX), ng + 1024, modl, 2, (bf16_t*)(ws + OFF_HX), ng + 2048, modl, 3, 4); break;
    case 9: run_gemm(smem, (const bf16_t*)(ws + OFF_HX), 1024, (const bf16_t*)(ws + OFF_BTF1), 2 * DFF, 1024, 1 << 20, 0, FSwiglu{(bf16_t*)(ws + OFF_H)}, G, c); break;
    case 10: run_gemm(smem, (const bf16_t*)(ws + OFF_H), DFF, (const bf16_t*)(ws + OFF_BTF2), 1024, DFF, 1 << 20, 0, FPlain{(bf16_t*)(ws + OFF_BR), 1024}, G, c); break;
    case 11:
        if (l + 1 < NLAYER) {
            rowwise(p, lnd(p.out), ctxres, lnd(p.out), ctxres, (const bf16_t*)(ws + OFF_BR), ng + 3072, modl, 5, (bf16_t*)(ws + OFF_HX), lnd(p.in[I_NORMG]) + (size_t)(l + 1) * 4 * 1024, modl + 9 * 6144, 0, 1);
            __syncthreads(); convert_weights(p, l + 1, lds);
        } else rowwise(p, lnd(p.out), ctxres, lnd(p.out), ctxres, (const bf16_t*)(ws + OFF_BR), ng + 3072, modl, 5, nullptr, nullptr, nullptr, 0, 0);
        break;
    }
}

__global__ void __launch_bounds__(512, 2) fwd_megakernel(Params p) {
    extern __shared__ __attribute__((aligned(16))) unsigned char smem[];
#ifndef PROBE_REP
#define PROBE_REP 0
#define PROBE_PH 0
#endif
    const int n_it = p.ph_hi + PROBE_REP;
    for (int it = p.ph_lo; it < n_it; ++it) {
        const int ph = it < p.ph_hi ? it : PROBE_PH;
        run_phase(p, ph, smem);
        if (it + 1 < n_it) { cg::this_grid().sync(); }
    }
}

extern "C" void kernel_launch(void* const* d_in, const int* in_sizes, int n_in, void* d_out, int out_size, void* d_ws, size_t ws_size, hipStream_t stream) {
    static int grid = 0;
    if (grid == 0) {
        if (n_in != 25 || ws_size < WS_END) { fprintf(stderr, "kernel_launch: need 25 inputs and %zu bytes of workspace (got %d, %zu)\n", (size_t)WS_END, n_in, ws_size); grid = -1; return; }
        int dev = 0, cus = 0, per_cu = 0;
        (void)hipGetDevice(&dev); (void)hipDeviceGetAttribute(&cus, hipDeviceAttributeMultiprocessorCount, dev);
        if (hipFuncSetAttribute((const void*)fwd_megakernel, hipFuncAttributeMaxDynamicSharedMemorySize, LDS_BYTES) != hipSuccess) { fprintf(stderr, "kernel_launch: hipFuncSetAttribute failed\n"); grid = -1; return; }
        if (hipOccupancyMaxActiveBlocksPerMultiprocessor(&per_cu, (const void*)fwd_megakernel, 512, LDS_BYTES) != hipSuccess || per_cu < 1) { fprintf(stderr, "kernel_launch: occupancy query gave %d\n", per_cu); per_cu = 1; }
        (void)hipGetLastError();
        grid = cus * 1;
    }
    if (grid < 0) return;
    Params p{};
    for (int i = 0; i < 25; ++i) p.in[i] = (const float*)d_in[i];
    p.out = (float*)d_out; p.ws = (unsigned char*)d_ws;
#if MULTI_LAUNCH
    for (int ph = 0; ph < NPHASE; ++ph) { p.ph_lo = ph; p.ph_hi = ph + 1; hipLaunchKernelGGL(fwd_megakernel, dim3(grid), dim3(512), LDS_BYTES, stream, p); }
#else
    p.ph_lo = 0; p.ph_hi = NPHASE;
    void* args[] = {&p};
    hipError_t e = hipLaunchCooperativeKernel((const void*)fwd_megakernel, dim3(grid), dim3(512), args, LDS_BYTES, stream);
    if (e != hipSuccess) fprintf(stderr, "cooperative launch failed: %s (grid %d)\n", hipGetErrorString(e), grid);
#endif
}
```

```cpp
#include <hip/hip_runtime.h>
#include <hip/hip_cooperative_groups.h>
#include <cstdio>
namespace cg = cooperative_groups;

#ifndef MULTI_LAUNCH
#define MULTI_LAUNCH 0
#endif

typedef unsigned short bf16_t;
typedef short bf16x8 __attribute__((ext_vector_type(8)));
typedef float f32x4 __attribute__((ext_vector_type(4)));

constexpr int NB = 8, SEQ = 8192, DM = 1024, CTXL = 256;
constexpr int TL = NB * SEQ, TC = NB * CTXL, TT = TL + TC;
constexpr int DIN = 7936, DFF = 2816, NPROJ = 4864, MIXW = 512;
constexpr int NLAYER = 2;

constexpr size_t SZ_BTIN = (size_t)DIN * 1024 * 2, SZ_BTUP = (size_t)3072 * 512 * 2, SZ_BTO3 = (size_t)1024 * 3072 * 2,
                 SZ_BTF1 = (size_t)5632 * 1024 * 2, SZ_BTF2 = (size_t)1024 * 2816 * 2, SZ_BTG2 = (size_t)512 * 256 * 2;
constexpr size_t OFF_BTIN = 0, OFF_BTUP = OFF_BTIN + SZ_BTIN, OFF_BTO3 = OFF_BTUP + SZ_BTUP, OFF_BTF1 = OFF_BTO3 + SZ_BTO3,
                 OFF_BTF2 = OFF_BTF1 + SZ_BTF1, OFF_BTG2 = OFF_BTF2 + SZ_BTF2, OFF_MISC = OFF_BTG2 + SZ_BTG2;
constexpr size_t OFF_MOD = OFF_MISC;
constexpr size_t OFF_ROPE = OFF_MOD + (size_t)2 * 9 * 6144 * 4;
constexpr size_t OFF_CTXRES = OFF_MISC + (1u << 20);
constexpr size_t OFF_HX = OFF_CTXRES + (size_t)TC * 1024 * 4;
constexpr size_t SZ_HX = (size_t)TT * 1024 * 2;
constexpr size_t SZ_SEG = (size_t)TT * 1536 * 2;
constexpr size_t OFF_SCONV = OFF_HX + SZ_HX, OFF_SATTN = OFF_SCONV + SZ_SEG, OFF_SRKV = OFF_SATTN + SZ_SEG, OFF_SLORA = OFF_SRKV + SZ_SEG;
constexpr size_t OFF_BR = OFF_SLORA + (size_t)TT * 256 * 2;
constexpr size_t SZ_BR1 = (size_t)TT * 512 * 2;
constexpr size_t WS_END = OFF_BR + 3 * SZ_BR1;
constexpr size_t OFF_BON = OFF_SCONV;
constexpr size_t OFF_KF = OFF_HX;
constexpr size_t OFF_KFC = OFF_KF + (size_t)TL * 512 * 2;
constexpr size_t OFF_VT = OFF_KFC + (size_t)TC * 512 * 2;
constexpr size_t OFF_VTC = OFF_VT + (size_t)TL * 512 * 2;
constexpr size_t OFF_Y = OFF_HX;
constexpr size_t OFF_G = OFF_SCONV;
constexpr size_t OFF_H = OFF_SCONV;
constexpr size_t OFF_HXB = OFF_SRKV;

constexpr int LDS_BYTES = 144 * 1024;

struct Params {
    const float* in[25];
    float* out;
    unsigned char* ws;
    int ph_lo, ph_hi;
};
enum { I_X = 0, I_C, I_CTX, I_CCTX, I_WADA, I_BADA, I_NORMG, I_WIN, I_CONVW, I_MU, I_W0, I_W2, I_A0, I_A2, I_KK, I_KA, I_RK, I_G2, I_LNXG, I_LNXB, I_RPB, I_WUP, I_WO, I_WF1, I_WF2 };

__device__ __forceinline__ float bf2f(unsigned v16) { return __uint_as_float(v16 << 16); }
__device__ __forceinline__ float bflo(unsigned u) { return __uint_as_float(u << 16); }
__device__ __forceinline__ float bfhi(unsigned u) { return __uint_as_float(u & 0xffff0000u); }
__device__ __forceinline__ unsigned cvtpk(float lo, float hi) { unsigned r; asm volatile("v_cvt_pk_bf16_f32 %0, %1, %2" : "=v"(r) : "v"(lo), "v"(hi)); return r; }
__device__ __forceinline__ bf16_t f2bf(float f) { return (bf16_t)(cvtpk(f, 0.f) & 0xffffu); }
template <int CTRL> __device__ __forceinline__ float dpp(float x) { return __builtin_bit_cast(float, __builtin_amdgcn_mov_dpp(__builtin_bit_cast(int, x), CTRL, 0xf, 0xf, true)); }
constexpr int XOR1 = 0xB1, XOR2 = 0x4E, XOR7 = 0x141, XOR8 = 0x128;
__device__ __forceinline__ float sum8(float x) { x += dpp<XOR1>(x); x += dpp<XOR2>(x); x += dpp<XOR7>(x); return x; }
__device__ __forceinline__ float sum16(float x) { x = sum8(x); x += dpp<XOR8>(x); return x; }
__device__ __forceinline__ float xrow16_max(float x) {
    auto s = __builtin_amdgcn_permlane16_swap(__float_as_uint(x), __float_as_uint(x), false, false);
    x = fmaxf(__uint_as_float(s[0]), __uint_as_float(s[1]));
    auto t = __builtin_amdgcn_permlane32_swap(__float_as_uint(x), __float_as_uint(x), false, false);
    return fmaxf(__uint_as_float(t[0]), __uint_as_float(t[1]));
}
__device__ __forceinline__ float xrow16_sum(float x) {
    auto s = __builtin_amdgcn_permlane16_swap(__float_as_uint(x), __float_as_uint(x), false, false);
    x = __uint_as_float(s[0]) + __uint_as_float(s[1]);
    auto t = __builtin_amdgcn_permlane32_swap(__float_as_uint(x), __float_as_uint(x), false, false);
    return __uint_as_float(t[0]) + __uint_as_float(t[1]);
}
__device__ __forceinline__ float wave_sum(float x) { return xrow16_sum(sum16(x)); }
template <class T> __device__ __forceinline__ T* lnd(T* q) { const unsigned long long v = (unsigned long long)q; unsigned lo = __builtin_amdgcn_readfirstlane((unsigned)v), hi = __builtin_amdgcn_readfirstlane((unsigned)(v >> 32)); asm volatile("" : "+s"(lo), "+s"(hi)); typedef __attribute__((address_space(1))) T* gp_t; return (T*)(gp_t)(((unsigned long long)hi << 32) | lo); }
__device__ __forceinline__ int my_tid() { int t = threadIdx.x; asm volatile("" : "+v"(t)); return t; }
__device__ __forceinline__ int my_bid() { int t = __builtin_amdgcn_readfirstlane(blockIdx.x); asm volatile("" : "+s"(t)); return t; }
__device__ __forceinline__ int my_nb() { int t = __builtin_amdgcn_readfirstlane(gridDim.x); asm volatile("" : "+s"(t)); return t; }
__device__ __forceinline__ float sigmoidf_(float x) { return __builtin_amdgcn_rcpf(1.f + __expf(-x)); }
__device__ __forceinline__ float tanh_fast(float x) { return 1.f - 2.f * __builtin_amdgcn_rcpf(1.f + __expf(2.f * x)); }

namespace pg8 {
#define PG8_LAS __attribute__((address_space(3)))
constexpr int BM = 256, BK = 64, HALF = 128, HTB = HALF * BK * 2, STAGE_BYTES = 8 * HTB, NXCD = 8, WGM = 8;
__host__ __device__ __forceinline__ int lds_byte(int r, int c) { const int st = (r >> 4) * 2 + (c >> 5), rr = r & 15, cc = c & 31, ob = rr * 64 + cc * 2; return st * 1024 + (ob ^ (((ob >> 9) & 1) << 5)); }
__host__ __device__ __forceinline__ void stage_rc(int b, int& R, int& C) { const int st = b / 1024, sb = b % 1024, swz = sb ^ (((sb >> 9) & 1) << 5); R = (st >> 1) * 16 + swz / 64; C = (st & 1) * 32 + (swz % 64) / 2; }
struct Unit { int pm, pn; };
struct Gemm { const bf16_t* A; const bf16_t* Bt; int M, N, K, lda; int a_div; size_t a_bstride; };
struct StaticOrder {
    int nM, nN, nwg, G, c;
    __host__ __device__ void init(int M, int N, int G_, int c_) { nM = M / BM; nN = N / BM; nwg = nM * nN; G = G_; c = c_; }
    __host__ __device__ bool next(int i, Unit& u) const {
        const long L = (long)i * G + c; if (L >= nwg) return false;
        int wgid = (int)L; { const int q = nwg / NXCD, r = nwg % NXCD, xcd = wgid % NXCD, off = wgid / NXCD; wgid = (xcd < r ? xcd * (q + 1) : r * (q + 1) + (xcd - r) * q) + off; }
        const int nig = WGM * nN, gid = wgid / nig, fm = gid * WGM, gsz = (nM - fm) < WGM ? (nM - fm) : WGM;
        u.pm = fm + ((wgid % nig) % gsz); u.pn = (wgid % nig) / gsz; return true;
    }
};

template <class Epi>
__device__ __forceinline__ void gemm_phase(PG8_LAS unsigned char* lds, const Gemm g, const StaticOrder& S, const Epi& E) {
    const int tid = my_tid(), wid = __builtin_amdgcn_readfirstlane(tid >> 6), lane = tid & 63, wr = wid >> 2, wc = wid & 3, fr = lane & 15, fq = lane >> 4;
    const int K = g.K, nt = K / BK, lda = g.lda;
    unsigned voffA[2], voffB[2];
#pragma unroll
    for (int i = 0; i < 2; ++i) { int R, C; stage_rc(tid * 16 + i * 8192, R, C);
        voffA[i] = (unsigned)(R * lda + C) * 2u; voffB[i] = (unsigned)(R * K + C) * 2u; }
    const size_t kstep = (size_t)(BK * 2);
    const size_t hsA = (size_t)HALF * lda * 2, hsB = (size_t)HALF * K * 2;
    const size_t tsA = 2 * hsA, tsB = 2 * hsB;
    const unsigned ldsw = (unsigned)wid * 1024u;
    const int aoff = lds_byte(wr * 64 + fr, fq * 8), boff = lds_byte(wc * 32 + fr, fq * 8);
#define PG8_SA(b, h) (((b) * 2 + (h)) * HTB)
#define PG8_SB(b, h) ((4 + (b) * 2 + (h)) * HTB)
#define PG8_STAGE(bufoff, gbase, voff) do { _Pragma("unroll") for (int _i = 0; _i < 2; ++_i) \
        __builtin_amdgcn_global_load_lds((const unsigned*)((const char*)(gbase) + (voff)[_i]), (PG8_LAS unsigned*)(lds + (bufoff) + ldsw + _i * 8192), 16, 0, 0); } while (0)
#define PG8_LDA(dst, b, h) do { _Pragma("unroll") for (int m = 0; m < 4; ++m) _Pragma("unroll") for (int k = 0; k < 2; ++k) dst[m][k] = *(const PG8_LAS bf16x8*)(lds + PG8_SA(b, h) + aoff + m * 2048 + k * 1024); } while (0)
#define PG8_LDB(dst, b, h) do { _Pragma("unroll") for (int n = 0; n < 2; ++n) _Pragma("unroll") for (int k = 0; k < 2; ++k) dst[n][k] = *(const PG8_LAS bf16x8*)(lds + PG8_SB(b, h) + boff + n * 2048 + k * 1024); } while (0)
#define PG8_MMA(ai, bj, At, Bt) do { __builtin_amdgcn_s_setprio(1); _Pragma("unroll") for (int m = 0; m < 4; ++m) _Pragma("unroll") for (int n = 0; n < 2; ++n) _Pragma("unroll") for (int k = 0; k < 2; ++k) \
        acc[ai][bj][m][n] = __builtin_amdgcn_mfma_f32_16x16x32_bf16(Bt[n][k], At[m][k], acc[ai][bj][m][n], 0, 0, 0); __builtin_amdgcn_s_setprio(0); } while (0)
#define PG8_WAIT_V(n) asm volatile("s_waitcnt vmcnt(" #n ")" ::: "memory")
#define PG8_WAIT_L(n) asm volatile("s_waitcnt lgkmcnt(" #n ")" ::: "memory")
#define PG8_BAR __builtin_amdgcn_s_barrier()
#define PG8_SCHED __builtin_amdgcn_sched_barrier(0)
#define PG8_APTR(u) ((const char*)g.A + (size_t)((u).pn / g.a_div) * g.a_bstride + (size_t)(u).pm * tsA)
    Unit cur, nxt; int ui = 0;
    if (!S.next(0, cur)) return;
    f32x4 acc[2][2][4][2];
#pragma unroll
    for (int a = 0; a < 2; ++a)
#pragma unroll
        for (int b = 0; b < 2; ++b)
#pragma unroll
            for (int m = 0; m < 4; ++m)
#pragma unroll
                for (int n = 0; n < 2; ++n) acc[a][b][m][n] = (f32x4){0.f, 0.f, 0.f, 0.f};
    bf16x8 At[4][2], B0[2][2], B1[2][2];
    const char* cA = PG8_APTR(cur); const char* cB = (const char*)g.Bt + (size_t)cur.pn * tsB;
    PG8_STAGE(PG8_SB(0, 0), cB, voffB); PG8_STAGE(PG8_SA(0, 0), cA, voffA); PG8_STAGE(PG8_SB(0, 1), cB + hsB, voffB); PG8_STAGE(PG8_SA(0, 1), cA + hsA, voffA);
    if (wr == 1) PG8_BAR;
    PG8_WAIT_V(4); PG8_BAR;
    PG8_STAGE(PG8_SB(1, 0), cB + kstep, voffB); PG8_STAGE(PG8_SA(1, 0), cA + kstep, voffA); PG8_STAGE(PG8_SB(1, 1), cB + hsB + kstep, voffB);
    PG8_WAIT_V(6); PG8_BAR;
    for (;;) {
        const bool has_next = S.next(ui + 1, nxt);
        const char* nA = has_next ? PG8_APTR(nxt) : cA; const char* nB = has_next ? (const char*)g.Bt + (size_t)nxt.pn * tsB : cB;
        for (int t = 0; t < nt; t += 2) {
            const bool last = (t == nt - 2);
            const char* a1 = cA + (size_t)(t + 1) * kstep;
            const char* a2 = last ? nA : cA + (size_t)(t + 2) * kstep; const char* b2 = last ? nB : cB + (size_t)(t + 2) * kstep;
            const char* a3 = a2 + kstep; const char* b3 = b2 + kstep;
            PG8_LDB(B0, 0, 0); PG8_SCHED; PG8_LDA(At, 0, 0); PG8_STAGE(PG8_SA(1, 1), a1 + hsA, voffA);
            PG8_WAIT_L(8); PG8_BAR; PG8_WAIT_L(0); PG8_MMA(0, 0, At, B0); PG8_BAR; PG8_SCHED;
            PG8_LDB(B1, 0, 1); PG8_STAGE(PG8_SB(0, 0), b2, voffB);
            PG8_BAR; PG8_WAIT_L(0); PG8_MMA(0, 1, At, B1); PG8_BAR;
            PG8_LDA(At, 0, 1); PG8_STAGE(PG8_SA(0, 0), a2, voffA);
            PG8_BAR; PG8_WAIT_L(0); PG8_MMA(1, 0, At, B0); PG8_BAR; PG8_SCHED;
            PG8_STAGE(PG8_SB(0, 1), b2 + hsB, voffB);
            PG8_WAIT_V(6); PG8_BAR; PG8_MMA(1, 1, At, B1); PG8_BAR;
            PG8_LDB(B0, 1, 0); PG8_SCHED; PG8_LDA(At, 1, 0); PG8_STAGE(PG8_SA(0, 1), a2 + hsA, voffA);
            PG8_WAIT_L(8); PG8_BAR; PG8_WAIT_L(0); PG8_MMA(0, 0, At, B0); PG8_BAR; PG8_SCHED;
            PG8_LDB(B1, 1, 1); PG8_STAGE(PG8_SB(1, 0), b3, voffB);
            PG8_BAR; PG8_WAIT_L(0); PG8_MMA(0, 1, At, B1); PG8_BAR;
            PG8_LDA(At, 1, 1); PG8_STAGE(PG8_SA(1, 0), a3, voffA);
            PG8_BAR; PG8_WAIT_L(0); PG8_MMA(1, 0, At, B0); PG8_BAR; PG8_SCHED;
            PG8_STAGE(PG8_SB(1, 1), b3 + hsB, voffB);
            PG8_WAIT_V(6); PG8_BAR; PG8_MMA(1, 1, At, B1); PG8_BAR;
        }
        E(acc, cur, wr, wc, fr, fq);
        if (!has_next) break;
#pragma unroll
        for (int a = 0; a < 2; ++a)
#pragma unroll
            for (int b = 0; b < 2; ++b)
#pragma unroll
                for (int m = 0; m < 4; ++m)
#pragma unroll
                    for (int n = 0; n < 2; ++n) acc[a][b][m][n] = (f32x4){0.f, 0.f, 0.f, 0.f};
        cur = nxt; cA = nA; cB = nB; ++ui;
    }
    PG8_WAIT_V(0);
    if (wr == 0) PG8_BAR;
    PG8_BAR;
#undef PG8_SA
#undef PG8_SB
#undef PG8_STAGE
#undef PG8_LDA
#undef PG8_LDB
#undef PG8_MMA
#undef PG8_WAIT_V
#undef PG8_WAIT_L
#undef PG8_BAR
#undef PG8_SCHED
#undef PG8_APTR
}

template <class F> struct EpiT {
    F f;
    __device__ __forceinline__ void operator()(const f32x4 (&acc)[2][2][4][2], const Unit& u, int wr, int wc, int fr, int fq) const {
        const int row0 = u.pm * BM + wr * 64 + fr;
#pragma unroll
        for (int ai = 0; ai < 2; ++ai)
#pragma unroll
            for (int m = 0; m < 4; ++m) {
                const int row = row0 + ai * HALF + m * 16;
#pragma unroll
                for (int bj = 0; bj < 2; ++bj) f(row, u.pn, bj * HALF + wc * 32 + fq * 4, acc[ai][bj][m][0], acc[ai][bj][m][1]);
            }
    }
};
}


__device__ __forceinline__ void st4bf(bf16_t* p, f32x4 v) { *(uint2*)p = make_uint2(cvtpk(v[0], v[1]), cvtpk(v[2], v[3])); }

struct FProj {
    unsigned char* ws;
    __device__ __forceinline__ void operator()(int row, int pn, int cw, f32x4 v0, f32x4 v1) const {
        bf16_t* p;
        if (pn < 18) { const int seg = pn / 6; p = (bf16_t*)(ws + OFF_SCONV + (size_t)seg * SZ_SEG) + (size_t)row * 1536 + (pn - seg * 6) * 256 + cw; }
        else p = (bf16_t*)(ws + OFF_SLORA) + (size_t)row * 256 + cw;
        st4bf(p, v0); st4bf(p + 16, v1);
    }
};
struct FPlain { bf16_t* O; int ld;
    __device__ __forceinline__ void operator()(int row, int pn, int cw, f32x4 v0, f32x4 v1) const {
        bf16_t* p = O + (size_t)row * ld + pn * 256 + cw; st4bf(p, v0); st4bf(p + 16, v1); } };
struct FSig { bf16_t* O; int ld;
    __device__ __forceinline__ void operator()(int row, int pn, int cw, f32x4 v0, f32x4 v1) const {
        bf16_t* p = O + (size_t)row * ld + pn * 256 + cw;
#pragma unroll
        for (int j = 0; j < 4; ++j) { v0[j] = sigmoidf_(v0[j]); v1[j] = sigmoidf_(v1[j]); }
        st4bf(p, v0); st4bf(p + 16, v1); } };
struct FMulG { bf16_t* G; int ld;
    __device__ __forceinline__ void operator()(int row, int pn, int cw, f32x4 v0, f32x4 v1) const {
        bf16_t* p = G + (size_t)row * ld + pn * 256 + cw;
        const uint2 g0 = *(const uint2*)p, g1 = *(const uint2*)(p + 16);
        v0[0] *= bflo(g0.x); v0[1] *= bfhi(g0.x); v0[2] *= bflo(g0.y); v0[3] *= bfhi(g0.y);
        v1[0] *= bflo(g1.x); v1[1] *= bfhi(g1.x); v1[2] *= bflo(g1.y); v1[3] *= bfhi(g1.y);
        st4bf(p, v0); st4bf(p + 16, v1); } };
struct FSwiglu { bf16_t* H;
    __device__ __forceinline__ void operator()(int row, int pn, int cw, f32x4 a, f32x4 b) const {
        const int hc = pn * 128 + (cw >> 5) * 16 + (cw & 15);
        f32x4 o;
#pragma unroll
        for (int j = 0; j < 4; ++j) o[j] = a[j] * sigmoidf_(a[j]) * b[j];
        st4bf(H + (size_t)row * DFF + hc, o); } };

template <class F>
__device__ __forceinline__ void run_gemm(unsigned char* smem, const bf16_t* A, int lda, const bf16_t* Bt, int N, int K, int a_div, size_t a_bstride, const F& f, int G, int c) {
    pg8::Gemm g; g.A = A; g.Bt = Bt; g.M = TT; g.N = N; g.K = K; g.lda = lda; g.a_div = a_div; g.a_bstride = a_bstride;
    pg8::StaticOrder S; S.init(TT, N, G, c);
    pg8::EpiT<F> E{f};
    pg8::gemm_phase(( PG8_LAS unsigned char*)smem, g, S, E);
}

__device__ __forceinline__ int mapcol(int mode, int n) {
    if (mode == 1) return n < 1536 ? n : (n < 3072 ? n + 1792 : (n < 4864 ? n - 1536 : n));
    if (mode == 2) { const int g = n >> 5, w = n & 31; return w < 16 ? 16 * g + w : DFF + 16 * g + (w - 16); }
    return n;
}
__device__ void xpose(const float* __restrict__ src, int src_ld, int K, int N, bf16_t* __restrict__ dst, int dst_ld, int dst_koff, int mode, float* tile, int rot) {
    const int ntk = K / 64, ntn = N / 64, tid = my_tid();
    const int bid = (int)((my_bid() + (unsigned)rot) % my_nb());
    for (int t = bid; t < ntk * ntn; t += my_nb()) {
        const int tk = t % ntk, tn = t / ntk;
#pragma unroll
        for (int p = 0; p < 8; ++p) { const int k = p * 8 + (tid >> 6), n = tid & 63;
            tile[k * 65 + n] = src[(size_t)(tk * 64 + k) * src_ld + mapcol(mode, tn * 64 + n)]; }
        __syncthreads();
#pragma unroll
        for (int p = 0; p < 8; ++p) { const int n = p * 8 + (tid >> 6), k = tid & 63;
            dst[(size_t)(tn * 64 + n) * dst_ld + dst_koff + tk * 64 + k] = f2bf(tile[k * 65 + n]); }
        __syncthreads();
    }
}
__device__ void convert_weights(const Params& p, int l, float* tile) {
    unsigned char* ws = lnd(p.ws);
    xpose(lnd(p.in[I_WIN]) + (size_t)l * 1024 * DIN, DIN, 1024, DIN, (bf16_t*)(ws + OFF_BTIN), 1024, 0, 1, tile, 0);
    for (int b = 0; b < 3; ++b) xpose(lnd(p.in[I_WUP]) + ((size_t)l * 3 + b) * 512 * 1024, 1024, 512, 1024, (bf16_t*)(ws + OFF_BTUP) + (size_t)b * 1024 * 512, 512, 0, 0, tile, 64 + b * 64);
    for (int b = 0; b < 3; ++b) xpose(lnd(p.in[I_WO]) + (size_t)l * 1024 * 1024, 1024, 1024, 1024, (bf16_t*)(ws + OFF_BTO3), 3072, b * 1024, 0, tile, 0);
    xpose(lnd(p.in[I_WF1]) + (size_t)l * 1024 * 2 * DFF, 2 * DFF, 1024, 2 * DFF, (bf16_t*)(ws + OFF_BTF1), 1024, 0, 2, tile, 0);
    xpose(lnd(p.in[I_WF2]) + (size_t)l * DFF * 1024, 1024, DFF, 1024, (bf16_t*)(ws + OFF_BTF2), DFF, 0, 0, tile, 128);
    xpose(lnd(p.in[I_G2]) + (size_t)l * 128 * 512, 512, 128, 512, (bf16_t*)(ws + OFF_BTG2), 256, 128, 0, tile, 200);
    bf16_t* g2 = (bf16_t*)(ws + OFF_BTG2);
    for (int i = my_bid() * 512 + my_tid(); i < 512 * 128; i += my_nb() * 512) g2[(i >> 7) * 256 + (i & 127)] = 0;
}

__device__ void prologue_mods(const Params& p, float* lds) {
    float* sc = lds;
    float* red = lds + 9 * 1024;
    const int tid = my_tid();
    for (int e = tid; e < 9 * 1024; e += 512) { const int v = e >> 10, k = e & 1023; const float x = v < 8 ? lnd(p.in[I_C])[v * 1024 + k] : lnd(p.in[I_CCTX])[k]; sc[e] = x * sigmoidf_(x); }
    __syncthreads();
    const int kg = tid >> 4, cl = tid & 15;
    float* mod = (float*)(lnd(p.ws) + OFF_MOD);
    for (int cgp = my_bid(); cgp < 2 * 384; cgp += my_nb()) {
        const int l = cgp / 384, col = (cgp % 384) * 16 + cl;
        float acc[9];
#pragma unroll
        for (int v = 0; v < 9; ++v) acc[v] = 0.f;
        const float* w = lnd(p.in[I_WADA]) + (size_t)l * 1024 * 6144 + col;
        for (int k = kg * 32; k < kg * 32 + 32; ++k) { const float wv = w[(size_t)k * 6144];
#pragma unroll
            for (int v = 0; v < 9; ++v) acc[v] += sc[v * 1024 + k] * wv; }
#pragma unroll
        for (int v = 0; v < 9; ++v) red[(kg * 16 + cl) * 9 + v] = acc[v];
        __syncthreads();
        if (tid < 144) { const int c2 = tid / 9, v = tid % 9; float s = 0.f;
            for (int g = 0; g < 32; ++g) s += red[(g * 16 + c2) * 9 + v];
            const int cc = (cgp % 384) * 16 + c2;
            mod[((size_t)l * 9 + v) * 6144 + cc] = s + lnd(p.in[I_BADA])[l * 6144 + cc]; }
        __syncthreads();
    }
    float* rope = (float*)(lnd(p.ws) + OFF_ROPE);
    for (int i = my_bid() * 512 + tid; i < 192 * 16; i += my_nb() * 512) {
        const int pos = i >> 4, j = i & 15; const int pp = pos < 128 ? pos : pos - 128;
        const float fr = exp2f(-(float)j * 0.83048202372f);
        const float ang = (float)pp * fr;
        rope[i] = __cosf(ang); rope[192 * 16 + i] = __sinf(ang);
    }
}

__device__ void rowwise(const Params& p, const float* xs_lat, const float* xs_ctx, float* xd_lat, float* xd_ctx,
                        const bf16_t* Y, const float* gy, const float* modY, int gate_chunk,
                        bf16_t* HXo, const float* gh, const float* modH, int sh_chunk, int sc_chunk) {
    const int tid = my_tid(); const int lane = tid & 63, gw = my_bid() * 8 + (tid >> 6), nw = my_nb() * 8;
    for (int row = gw; row < TT; row += nw) {
        const bool lat = row < TL;
        const int v = lat ? (row >> 13) : 8;
        const float* xr = lat ? xs_lat + (size_t)row * 1024 : xs_ctx + (size_t)(row - TL) * 1024;
        float4 x[4];
#pragma unroll
        for (int i = 0; i < 4; ++i) x[i] = *(const float4*)(xr + i * 256 + lane * 4);
        if (Y) {
            float y[16]; float ss = 0.f;
#pragma unroll
            for (int i = 0; i < 4; ++i) { const uint2 u = *(const uint2*)(Y + (size_t)row * 1024 + i * 256 + lane * 4);
                y[4 * i] = bflo(u.x); y[4 * i + 1] = bfhi(u.x); y[4 * i + 2] = bflo(u.y); y[4 * i + 3] = bfhi(u.y); }
#pragma unroll
            for (int i = 0; i < 16; ++i) ss += y[i] * y[i];
            ss = wave_sum(ss);
            const float rn = rsqrtf(ss * (1.f / 1024.f) + 1e-6f);
            const float* gt = modY + (size_t)v * 6144 + gate_chunk * 1024;
#pragma unroll
            for (int i = 0; i < 4; ++i) { const int c = i * 256 + lane * 4; const float4 g = *(const float4*)(gy + c), t = *(const float4*)(gt + c);
                x[i].x += t.x * (y[4 * i] * rn * g.x); x[i].y += t.y * (y[4 * i + 1] * rn * g.y); x[i].z += t.z * (y[4 * i + 2] * rn * g.z); x[i].w += t.w * (y[4 * i + 3] * rn * g.w); }
            float* xw = lat ? xd_lat + (size_t)row * 1024 : xd_ctx + (size_t)(row - TL) * 1024;
#pragma unroll
            for (int i = 0; i < 4; ++i) *(float4*)(xw + i * 256 + lane * 4) = x[i];
        }
        if (HXo) {
            float ss = 0.f;
#pragma unroll
            for (int i = 0; i < 4; ++i) ss += x[i].x * x[i].x + x[i].y * x[i].y + x[i].z * x[i].z + x[i].w * x[i].w;
            ss = wave_sum(ss);
            const float rn = rsqrtf(ss * (1.f / 1024.f) + 1e-6f);
            const float* sh = modH + (size_t)v * 6144 + sh_chunk * 1024; const float* scp = modH + (size_t)v * 6144 + sc_chunk * 1024;
#pragma unroll
            for (int i = 0; i < 4; ++i) { const int c = i * 256 + lane * 4; const float4 g = *(const float4*)(gh + c), a = *(const float4*)(scp + c), b = *(const float4*)(sh + c);
                const float o0 = x[i].x * rn * g.x * (1.f + a.x) + b.x, o1 = x[i].y * rn * g.y * (1.f + a.y) + b.y, o2 = x[i].z * rn * g.z * (1.f + a.z) + b.z, o3 = x[i].w * rn * g.w * (1.f + a.w) + b.w;
                *(uint2*)(HXo + (size_t)row * 1024 + c) = make_uint2(cvtpk(o0, o1), cvtpk(o2, o3)); }
        }
    }
}

__device__ __forceinline__ void unpack8(const uint4 u, float* f) { f[0] = bflo(u.x); f[1] = bfhi(u.x); f[2] = bflo(u.y); f[3] = bfhi(u.y); f[4] = bflo(u.z); f[5] = bfhi(u.z); f[6] = bflo(u.w); f[7] = bfhi(u.w); }
__device__ __forceinline__ uint4 pack8(const float* f) { return make_uint4(cvtpk(f[0], f[1]), cvtpk(f[2], f[3]), cvtpk(f[4], f[5]), cvtpk(f[6], f[7])); }

__device__ void phase_elem(const Params& p, int l) {
    unsigned char* ws = lnd(p.ws);
    const bf16_t* SC = (const bf16_t*)(ws + OFF_SCONV);
    bf16_t* SA = (bf16_t*)(ws + OFF_SATTN);
    bf16_t* SL = (bf16_t*)(ws + OFF_SLORA);
    bf16_t* BR0 = (bf16_t*)(ws + OFF_BR);
    bf16_t* BR2 = (bf16_t*)(ws + OFF_BR + 2 * SZ_BR1);
    bf16_t* KF = (bf16_t*)(ws + OFF_KF); bf16_t* KFC = (bf16_t*)(ws + OFF_KFC);
    const float* cw = lnd(p.in[I_CONVW]) + (size_t)l * 3 * 512;
    const float* rope = (const float*)(ws + OFF_ROPE);
    const size_t gt = (size_t)my_bid() * 512 + my_tid(), gn = (size_t)my_nb() * 512;
    for (size_t idx = gt; idx < (size_t)TT * 64; idx += gn) {
        const int row = (int)(idx >> 6), c8 = (int)(idx & 63) * 8;
        bool hp, hn;
        if (row < TL) { const int t = row & 8191; hp = t > 0; hn = t < 8191; } else { const int t = (row - TL) & 255; hp = t > 0; hn = t < 255; }
        float z[3][8];
#pragma unroll
        for (int o = 0; o < 3; ++o) {
            const bool ok = o == 1 || (o == 0 ? hp : hn);
            if (ok) { const bf16_t* r = SC + (size_t)(row + o - 1) * 1536; float c[8], h[8]; unpack8(*(const uint4*)(r + 512 + c8), c); unpack8(*(const uint4*)(r + 1024 + c8), h);
#pragma unroll
                for (int e = 0; e < 8; ++e) z[o][e] = c[e] * h[e]; }
            else {
#pragma unroll
                for (int e = 0; e < 8; ++e) z[o][e] = 0.f; }
        }
        float bg[8], o8[8]; unpack8(*(const uint4*)(SC + (size_t)row * 1536 + c8), bg);
#pragma unroll
        for (int e = 0; e < 8; ++e) o8[e] = bg[e] * (cw[c8 + e] * z[0][e] + cw[512 + c8 + e] * z[1][e] + cw[1024 + c8 + e] * z[2][e]);
        *(uint4*)(BR0 + (size_t)row * 512 + c8) = pack8(o8);
    }
    for (size_t idx = gt; idx < (size_t)TL * 64; idx += gn) {
        const int row = (int)(idx >> 6), rem = (int)(idx & 63);
        const int which = rem >> 5, head = (rem >> 2) & 7, part = (rem >> 1) & 1, sub = rem & 1;
        const int t = row & 8191; const int pos = part == 0 ? (t >> 6) : 128 + (t & 63);
        const float* cs = rope + pos * 16 + sub * 8; const float* sn = cs + 192 * 16;
        const int off = which * 512 + head * 64 + part * 32 + sub * 8;
        const bf16_t* src = SA + (size_t)row * 1536 + off;
        float x1[8], x2[8], o1[8], o2[8]; unpack8(*(const uint4*)src, x1); unpack8(*(const uint4*)(src + 16), x2);
#pragma unroll
        for (int e = 0; e < 8; ++e) { o1[e] = x1[e] * cs[e] - x2[e] * sn[e]; o2[e] = x1[e] * sn[e] + x2[e] * cs[e]; }
        if (which == 0) { bf16_t* dst = BR2 + (size_t)row * 512 + head * 64 + part * 32 + sub * 8; *(uint4*)dst = pack8(o1); *(uint4*)(dst + 16) = pack8(o2); }
        else {
            const int bb = row >> 13, T = (t >> 2) & 1, r = t & 3, grp = t >> 3;
            bf16_t* dst = KF + ((((size_t)(bb * 8 + head) * 4 + (T * 2 + part)) * 1024 + grp) * 16 + (r * 4 + sub)) * 8;
            *(uint4*)dst = pack8(o1); *(uint4*)(dst + 16) = pack8(o2);
        }
    }
    for (size_t idx = gt; idx < (size_t)TC * 64; idx += gn) {
        const int rc = (int)(idx >> 6), ch = (int)(idx & 63);
        const int head = ch >> 3, chunk = ch & 7, bb = rc >> 8, t = rc & 255, T = (t >> 2) & 1, r = t & 3, grp = t >> 3;
        const uint4 v = *(const uint4*)(SA + (size_t)(TL + rc) * 1536 + 512 + head * 64 + chunk * 8);
        *(uint4*)(KFC + ((((size_t)(bb * 8 + head) * 4 + (T * 2 + (chunk >> 2))) * 32 + grp) * 16 + (r * 4 + (chunk & 3))) * 8) = v;
    }
    for (size_t idx = gt; idx < (size_t)TT * 16; idx += gn) {
        const int row = (int)(idx >> 4), c8 = 128 + (int)(idx & 15) * 8;
        bf16_t* q = SL + (size_t)row * 256 + c8; float f[8]; unpack8(*(const uint4*)q, f);
#pragma unroll
        for (int e = 0; e < 8; ++e) f[e] = sigmoidf_(f[e]);
        *(uint4*)q = pack8(f);
    }
}

__device__ void phase_vt(const Params& p, float* lds) {
    unsigned char* ws = lnd(p.ws);
    const bf16_t* SA = (const bf16_t*)(ws + OFF_SATTN);
    bf16_t* VT = (bf16_t*)(ws + OFF_VT); bf16_t* VTC = (bf16_t*)(ws + OFF_VTC);
    bf16_t* tile = (bf16_t*)lds;
    const int tid = my_tid();
    const int nlat = 8 * 8 * 128, nall = nlat + 8 * 8 * 4;
    for (int it = my_bid(); it < nall; it += my_nb()) {
        int b, h, t0, rowbase, tlen; bf16_t* dst;
        if (it < nlat) { b = it >> 10; h = (it >> 7) & 7; t0 = (it & 127) * 64; rowbase = b * 8192 + t0; tlen = 8192; dst = VT + ((size_t)(b * 8 + h) * 4) * 1024 * 128 + (size_t)(t0 >> 3) * 128; }
        else { const int j = it - nlat; b = j >> 5; h = (j >> 2) & 7; t0 = (j & 3) * 64; rowbase = TL + b * 256 + t0; tlen = 256; dst = VTC + ((size_t)(b * 8 + h) * 4) * 32 * 128 + (size_t)(t0 >> 3) * 128; }
        { const int tk = tid >> 3, d8 = (tid & 7) * 8;
          const uint4 u = *(const uint4*)(SA + (size_t)(rowbase + tk) * 1536 + 1024 + h * 64 + d8);
          bf16_t* tp = tile + tk * 66 + d8; ((unsigned*)tp)[0] = u.x; ((unsigned*)tp)[1] = u.y; ((unsigned*)tp)[2] = u.z; ((unsigned*)tp)[3] = u.w; }
        __syncthreads();
        { const int d = tid >> 3, k8 = (tid & 7) * 8;
          unsigned o[4];
#pragma unroll
          for (int e = 0; e < 4; ++e) o[e] = (unsigned)tile[(k8 + 2 * e) * 66 + d] | ((unsigned)tile[(k8 + 2 * e + 1) * 66 + d] << 16);
          *(uint4*)(dst + ((size_t)(d >> 4) * (tlen >> 3) + (k8 >> 3)) * 128 + (d & 15) * 8) = make_uint4(o[0], o[1], o[2], o[3]); }
        __syncthreads();
    }
}

struct AttnCtx { const bf16_t* KF; const bf16_t* KFC; const bf16_t* VT; const bf16_t* VTC; int b, h, g4, ql, nband, row_start, c0; };
__device__ __forceinline__ void attn_load(const AttnCtx& C, int sp, bf16x8 (&kf)[4], bf16x8 (&vf)[4]) {
    const bf16_t* kp; const bf16_t* vp; size_t ps;
    if (sp < C.nband) { const int g0 = ((C.row_start + sp) * 64 + C.c0) >> 3; kp = C.KF + (size_t)g0 * 128; vp = C.VT + (size_t)g0 * 128; ps = 1024 * 128; }
    else { const int g0 = (sp - C.nband) * 4; kp = C.KFC + (size_t)g0 * 128; vp = C.VTC + (size_t)g0 * 128; ps = 32 * 128; }
    const bf16_t* kq = kp + ((C.ql >> 2) * 16 + (C.ql & 3) * 4 + C.g4) * 8;
    const bf16_t* vq = vp + (C.g4 * 16 + C.ql) * 8;
#pragma unroll
    for (int pl = 0; pl < 4; ++pl) { kf[pl] = *(const bf16x8*)(kq + pl * ps); vf[pl] = *(const bf16x8*)(vq + pl * ps); }
}
struct AttnState { float m_run, l_run; f32x4 O[4]; };
__device__ __forceinline__ void attn_span(const AttnCtx& C, int sp, const bf16x8 (&kf)[4], const bf16x8 (&vf)[4], const bf16x8 (&qr)[2], const bf16x8 (&qp)[2],
                                          const float* rb, int i, int qcol, int col_start, AttnState& st) {
    const f32x4 zero4 = (f32x4){0.f, 0.f, 0.f, 0.f};
    const bool band = sp < C.nband;
    const bf16x8 q0 = band ? qr[0] : qp[0], q1 = band ? qr[1] : qp[1];
    f32x4 s0 = __builtin_amdgcn_mfma_f32_16x16x32_bf16(kf[0], q0, zero4, 0, 0, 0); s0 = __builtin_amdgcn_mfma_f32_16x16x32_bf16(kf[1], q1, s0, 0, 0, 0);
    f32x4 s1 = __builtin_amdgcn_mfma_f32_16x16x32_bf16(kf[2], q0, zero4, 0, 0, 0); s1 = __builtin_amdgcn_mfma_f32_16x16x32_bf16(kf[3], q1, s1, 0, 0, 0);
    float sc[8]; float mx = -1e30f;
    if (band) {
        const int krow = C.row_start + sp; const float* rbr = rb + (krow - i + 7) * 31;
#pragma unroll
        for (int e = 0; e < 8; ++e) {
            const int kc = C.c0 + 8 * C.g4 + e; const int dc = min(max(kc - qcol + 15, 0), 30);
            const float raw = e < 4 ? s0[e & 3] : s1[e & 3];
            const bool inw = kc >= col_start && kc < col_start + 16;
            sc[e] = inw ? raw * 0.125f + rbr[dc] : -1e30f; mx = fmaxf(mx, sc[e]);
        }
    } else {
#pragma unroll
        for (int e = 0; e < 8; ++e) { sc[e] = (e < 4 ? s0[e & 3] : s1[e & 3]) * 0.125f; mx = fmaxf(mx, sc[e]); }
    }
    mx = xrow16_max(mx);
    const float m_new = fmaxf(st.m_run, mx), alpha = __expf(st.m_run - m_new); st.m_run = m_new;
    float ps = 0.f;
#pragma unroll
    for (int e = 0; e < 8; ++e) { sc[e] = __expf(sc[e] - m_new); ps += sc[e]; }
    st.l_run = st.l_run * alpha + ps;
    typedef unsigned u32x4 __attribute__((ext_vector_type(4)));
    const u32x4 uu = {cvtpk(sc[0], sc[1]), cvtpk(sc[2], sc[3]), cvtpk(sc[4], sc[5]), cvtpk(sc[6], sc[7])};
    const bf16x8 pf = __builtin_bit_cast(bf16x8, uu);
#pragma unroll
    for (int mt = 0; mt < 4; ++mt) { st.O[mt] *= alpha; st.O[mt] = __builtin_amdgcn_mfma_f32_16x16x32_bf16(vf[mt], pf, st.O[mt], 0, 0, 0); }
}
__device__ void attn_wave(const Params& p, const float* rpb_l  , bool is_ctx, int b, int h, int i, int g) {
    unsigned char* ws = lnd(p.ws);
    AttnCtx C;
    const bf16_t* SA = (const bf16_t*)(ws + OFF_SATTN);
    bf16_t* BR2 = (bf16_t*)(ws + OFF_BR + 2 * SZ_BR1);
    C.KF = (const bf16_t*)(ws + OFF_KF) + ((size_t)(b * 8 + h) * 4) * 1024 * 128;
    C.KFC = (const bf16_t*)(ws + OFF_KFC) + ((size_t)(b * 8 + h) * 4) * 32 * 128;
    C.VT = (const bf16_t*)(ws + OFF_VT) + ((size_t)(b * 8 + h) * 4) * 1024 * 128;
    C.VTC = (const bf16_t*)(ws + OFF_VTC) + ((size_t)(b * 8 + h) * 4) * 32 * 128;
    const int lane = my_tid() & 63;
    C.b = b; C.h = h; C.ql = lane & 15; C.g4 = lane >> 4;
    C.nband = is_ctx ? 0 : 8; C.row_start = min(max(i - 4, 0), 120); C.c0 = min(max(16 * g - 8, 0), 32);
    int rowq, qcol = 0;
    if (is_ctx) rowq = TL + b * 256 + g * 16 + C.ql; else { qcol = g * 16 + C.ql; rowq = b * 8192 + i * 64 + qcol; }
    const int col_start = min(max(qcol - 8, 0), 48);
    bf16x8 qp[2], qr[2];
    qp[0] = *(const bf16x8*)(SA + (size_t)rowq * 1536 + h * 64 + C.g4 * 8); qp[1] = *(const bf16x8*)(SA + (size_t)rowq * 1536 + h * 64 + 32 + C.g4 * 8);
    if (!is_ctx) { qr[0] = *(const bf16x8*)(BR2 + (size_t)rowq * 512 + h * 64 + C.g4 * 8); qr[1] = *(const bf16x8*)(BR2 + (size_t)rowq * 512 + h * 64 + 32 + C.g4 * 8); }
    else { qr[0] = qp[0]; qr[1] = qp[1]; }
    AttnState st; st.m_run = -1e30f; st.l_run = 0.f;
#pragma unroll
    for (int mt = 0; mt < 4; ++mt) st.O[mt] = (f32x4){0.f, 0.f, 0.f, 0.f};
    const float* rb = rpb_l + h * 465;
    const int nsp = C.nband + 8;
    bf16x8 kA[4], vA[4], kB[4], vB[4];
    attn_load(C, 0, kA, vA);
    for (int sp = 0; sp < nsp; sp += 2) {
        attn_load(C, sp + 1, kB, vB);
        attn_span(C, sp, kA, vA, qr, qp, rb, i, qcol, col_start, st);
        if (sp + 2 < nsp) attn_load(C, sp + 2, kA, vA);
        attn_span(C, sp + 1, kB, vB, qr, qp, rb, i, qcol, col_start, st);
    }
    const float inv = 1.f / xrow16_sum(st.l_run);
#pragma unroll
    for (int mt = 0; mt < 4; ++mt) st4bf(BR2 + (size_t)rowq * 512 + h * 64 + mt * 16 + 4 * C.g4, st.O[mt] * inv);
}

__device__ void phase_attn(const Params& p, int l, float* lds, int ab, int nab) {
    const int tid = my_tid(), w = tid >> 6;
    const float* rpb = lnd(p.in[I_RPB]) + (size_t)l * 8 * 465;
    for (int e = tid; e < 8 * 465; e += 512) lds[e] = rpb[e];
    __syncthreads();
    const int nlat = 8 * 128 * 4, nall = nlat + (l == 0 ? 128 : 0);
    for (int u = ab; u < nall; u += nab) {
        if (u < nlat) { const int b = u >> 9, i = (u >> 2) & 127, hp = u & 3; attn_wave(p, lds, false, b, 2 * hp + (w >> 2), i, w & 3); }
        else { const int j = u - nlat; const int b = j >> 4, hp = (j >> 2) & 3, qq = j & 3; attn_wave(p, lds, true, b, 2 * hp + (w >> 2), 0, 4 * qq + (w & 3)); }
    }
    __syncthreads();
}

constexpr int CH = 32;
__device__ void scan_head(const Params& p, int l, int hd, float* lds) {
    unsigned char* ws = lnd(p.ws);
    const bf16_t* SR = (const bf16_t*)(ws + OFF_SRKV);
    const bf16_t* SL = (const bf16_t*)(ws + OFF_SLORA);
    const int tid = my_tid();
    const int d = hd >> 6, b = (hd >> 3) & 7, h = hd & 7;
    bf16_t* BON = (bf16_t*)(ws + OFF_BON) + (size_t)d * TT * 512;
    bf16_t* YO = (bf16_t*)(ws + OFF_Y) + (size_t)d * TT * 512;
    float* w2s = lds; float* a2s = w2s + 4096;
    float* cR = a2s + 4096; float* cW = cR + CH * 64; float* cK = cW + CH * 64; float* cV = cK + CH * 64; float* cA = cV + CH * 64; float* cB = cA + CH * 64;
    float* tl = cB + CH * 64; float* lam = tl + CH * 64; float* Yl = lam + CH * 64; float* hp = Yl + CH * 64;
    __syncthreads();
    {
        const float* w2 = lnd(p.in[I_W2]) + (size_t)(l * 2 + d) * 64 * 512 + h * 64; const float* a2 = lnd(p.in[I_A2]) + (size_t)(l * 2 + d) * 64 * 512 + h * 64;
        for (int e = tid; e < 4096; e += 512) { const int j = e >> 6, i = e & 63; w2s[e] = w2[j * 512 + i]; a2s[e] = a2[j * 512 + i]; }
        if (tid < 64) {
            const float* mu = lnd(p.in[I_MU]) + (size_t)(l * 2 + d) * 1664;
            hp[0 * 64 + tid] = lnd(p.in[I_W0])[(l * 2 + d) * 512 + h * 64 + tid];
            hp[1 * 64 + tid] = lnd(p.in[I_A0])[(l * 2 + d) * 512 + h * 64 + tid];
            hp[2 * 64 + tid] = lnd(p.in[I_KK])[l * 512 + h * 64 + tid];
            hp[3 * 64 + tid] = lnd(p.in[I_KA])[l * 512 + h * 64 + tid];
            hp[4 * 64 + tid] = lnd(p.in[I_RK])[(l * 8 + h) * 64 + tid];
            hp[5 * 64 + tid] = mu[h * 64 + tid];
            hp[6 * 64 + tid] = mu[512 + h * 64 + tid];
            hp[7 * 64 + tid] = mu[1024 + h * 64 + tid];
            hp[8 * 64 + tid] = mu[1536 + tid];
            hp[9 * 64 + tid] = mu[1600 + tid];
        }
    }
    __syncthreads();
    float S[8];
#pragma unroll
    for (int e = 0; e < 8; ++e) S[e] = 0.f;
    const int irow = tid >> 3, js = tid & 7;
    const int slp = tid >> 4, c4 = tid & 15;
    for (int chunk = 0; chunk < (CTXL + SEQ) / CH; ++chunk) {
        const int s = chunk * CH + slp;
        int row, nrow; bool nv;
        if (s < CTXL) { const int li = d ? (CTXL - 1 - s) : s; row = TL + b * CTXL + li; nv = d ? (li < CTXL - 1) : (li > 0); }
        else { const int t = d ? (SEQ - 1 - (s - CTXL)) : (s - CTXL); row = b * SEQ + t; nv = d ? (t < SEQ - 1) : (t > 0); }
        nrow = d ? row + 1 : row - 1;
        float rm[4], km[4], vm[4];
        {
            const uint2 z2 = make_uint2(0u, 0u);
            const uint2 lw = *(const uint2*)(SL + (size_t)row * 256 + 4 * c4), la = *(const uint2*)(SL + (size_t)row * 256 + 64 + 4 * c4);
            const uint2 lwn = nv ? *(const uint2*)(SL + (size_t)nrow * 256 + 4 * c4) : z2, lan = nv ? *(const uint2*)(SL + (size_t)nrow * 256 + 64 + 4 * c4) : z2;
            const float x[4] = {bflo(lw.x), bfhi(lw.x), bflo(lw.y), bfhi(lw.y)}, xn[4] = {bflo(lwn.x), bfhi(lwn.x), bflo(lwn.y), bfhi(lwn.y)};
            const float y[4] = {bflo(la.x), bfhi(la.x), bflo(la.y), bfhi(la.y)}, yn[4] = {bflo(lan.x), bfhi(lan.x), bflo(lan.y), bfhi(lan.y)};
#pragma unroll
            for (int e = 0; e < 4; ++e) { tl[slp * 64 + 4 * c4 + e] = tanh_fast(x[e] + hp[8 * 64 + 4 * c4 + e] * (xn[e] - x[e])); lam[slp * 64 + 4 * c4 + e] = y[e] + hp[9 * 64 + 4 * c4 + e] * (yn[e] - y[e]); }
            const bf16_t* pr = SR + (size_t)row * 1536 + h * 64 + 4 * c4; const bf16_t* pn = SR + (size_t)nrow * 1536 + h * 64 + 4 * c4;
            const uint2 r0 = *(const uint2*)pr, k0 = *(const uint2*)(pr + 512), v0 = *(const uint2*)(pr + 1024);
            const uint2 r1 = nv ? *(const uint2*)pn : z2, k1 = nv ? *(const uint2*)(pn + 512) : z2, v1 = nv ? *(const uint2*)(pn + 1024) : z2;
            const float ra[4] = {bflo(r0.x), bfhi(r0.x), bflo(r0.y), bfhi(r0.y)}, rb[4] = {bflo(r1.x), bfhi(r1.x), bflo(r1.y), bfhi(r1.y)};
            const float ka[4] = {bflo(k0.x), bfhi(k0.x), bflo(k0.y), bfhi(k0.y)}, kb[4] = {bflo(k1.x), bfhi(k1.x), bflo(k1.y), bfhi(k1.y)};
            const float va[4] = {bflo(v0.x), bfhi(v0.x), bflo(v0.y), bfhi(v0.y)}, vb[4] = {bflo(v1.x), bfhi(v1.x), bflo(v1.y), bfhi(v1.y)};
#pragma unroll
            for (int e = 0; e < 4; ++e) { const int i = 4 * c4 + e;
                rm[e] = ra[e] + hp[5 * 64 + i] * (rb[e] - ra[e]); km[e] = ka[e] + hp[6 * 64 + i] * (kb[e] - ka[e]); vm[e] = va[e] + hp[7 * 64 + i] * (vb[e] - va[e]); }
        }
        __syncthreads();
        {
            float wl[4], al[4];
#pragma unroll
            for (int e = 0; e < 4; ++e) { wl[e] = hp[0 * 64 + 4 * c4 + e]; al[e] = hp[1 * 64 + 4 * c4 + e]; }
            for (int j4 = 0; j4 < 16; ++j4) {
                const float4 tv = *(const float4*)(tl + slp * 64 + 4 * j4), lv = *(const float4*)(lam + slp * 64 + 4 * j4);
                const float tj[4] = {tv.x, tv.y, tv.z, tv.w}, lj[4] = {lv.x, lv.y, lv.z, lv.w};
#pragma unroll
                for (int jj = 0; jj < 4; ++jj) { const float4 wv = *(const float4*)(w2s + (4 * j4 + jj) * 64 + 4 * c4), av = *(const float4*)(a2s + (4 * j4 + jj) * 64 + 4 * c4);
                    wl[0] += tj[jj] * wv.x; wl[1] += tj[jj] * wv.y; wl[2] += tj[jj] * wv.z; wl[3] += tj[jj] * wv.w;
                    al[0] += lj[jj] * av.x; al[1] += lj[jj] * av.y; al[2] += lj[jj] * av.z; al[3] += lj[jj] * av.w; }
            }
            float kk[4], ss = 0.f, rk = 0.f, ag[4], kmod[4];
#pragma unroll
            for (int e = 0; e < 4; ++e) { const int i = 4 * c4 + e;
                const float x = -wl[e]; const float sp = fmaxf(x, 0.f) + __logf(1.f + __expf(-fabsf(x)));
                const float wlog = -sp - 0.5f; cW[slp * 64 + i] = __expf(-__expf(wlog));
                ag[e] = sigmoidf_(al[e]);
                kk[e] = km[e] * hp[2 * 64 + i]; ss += kk[e] * kk[e];
                kmod[e] = km[e] * (1.f + (ag[e] - 1.f) * hp[3 * 64 + i]);
                rk += rm[e] * kmod[e] * hp[4 * 64 + i]; }
            ss = sum16(ss); rk = sum16(rk);
            const float rn = rsqrtf(fmaxf(ss, 1e-24f));
            float bo[4];
#pragma unroll
            for (int e = 0; e < 4; ++e) { const int i = 4 * c4 + e; kk[e] *= rn;
                cR[slp * 64 + i] = rm[e]; cK[slp * 64 + i] = kmod[e]; cV[slp * 64 + i] = vm[e]; cA[slp * 64 + i] = -kk[e]; cB[slp * 64 + i] = kk[e] * ag[e]; bo[e] = rk * vm[e]; }
            *(uint2*)(BON + (size_t)row * 512 + h * 64 + 4 * c4) = make_uint2(cvtpk(bo[0], bo[1]), cvtpk(bo[2], bo[3]));
        }
        __syncthreads();
        for (int sl = 0; sl < CH; ++sl) {
            const float4 a0 = *(const float4*)(cA + sl * 64 + 8 * js), a1 = *(const float4*)(cA + sl * 64 + 8 * js + 4);
            const float4 w0 = *(const float4*)(cW + sl * 64 + 8 * js), w1 = *(const float4*)(cW + sl * 64 + 8 * js + 4);
            const float4 k0 = *(const float4*)(cK + sl * 64 + 8 * js), k1 = *(const float4*)(cK + sl * 64 + 8 * js + 4);
            const float4 b0 = *(const float4*)(cB + sl * 64 + 8 * js), b1 = *(const float4*)(cB + sl * 64 + 8 * js + 4);
            const float4 r0 = *(const float4*)(cR + sl * 64 + 8 * js), r1 = *(const float4*)(cR + sl * 64 + 8 * js + 4);
            const float vv = cV[sl * 64 + irow];
            float sa = S[0] * a0.x + S[1] * a0.y + S[2] * a0.z + S[3] * a0.w + S[4] * a1.x + S[5] * a1.y + S[6] * a1.z + S[7] * a1.w;
            sa = sum8(sa);
            S[0] = S[0] * w0.x + (vv * k0.x + sa * b0.x); S[1] = S[1] * w0.y + (vv * k0.y + sa * b0.y); S[2] = S[2] * w0.z + (vv * k0.z + sa * b0.z); S[3] = S[3] * w0.w + (vv * k0.w + sa * b0.w);
            S[4] = S[4] * w1.x + (vv * k1.x + sa * b1.x); S[5] = S[5] * w1.y + (vv * k1.y + sa * b1.y); S[6] = S[6] * w1.z + (vv * k1.z + sa * b1.z); S[7] = S[7] * w1.w + (vv * k1.w + sa * b1.w);
            float y = S[0] * r0.x + S[1] * r0.y + S[2] * r0.z + S[3] * r0.w + S[4] * r1.x + S[5] * r1.y + S[6] * r1.z + S[7] * r1.w;
            y = sum8(y);
            if (js == 0) Yl[sl * 64 + irow] = y;
        }
        __syncthreads();
        { const float4 yv = *(const float4*)(Yl + slp * 64 + 4 * c4);
          *(uint2*)(YO + (size_t)row * 512 + h * 64 + 4 * c4) = make_uint2(cvtpk(yv.x, yv.y), cvtpk(yv.z, yv.w)); }
    }
    __syncthreads();
}


typedef float f32x2 __attribute__((ext_vector_type(2)));
struct StepOps { f32x2 a[4], w[4], k[4], b[4], r[4]; f32x2 vv; };
__device__ __forceinline__ void ld_step(StepOps& X, const float* buf, int sl, int js, int i0) {
    const float* q = buf + sl * 64 + 8 * js;
    const float4 r0 = *(const float4*)(q), r1 = *(const float4*)(q + 4);
    const float4 w0 = *(const float4*)(q + 2048), w1 = *(const float4*)(q + 2048 + 4);
    const float4 k0 = *(const float4*)(q + 4096), k1 = *(const float4*)(q + 4096 + 4);
    const float4 a0 = *(const float4*)(q + 8192), a1 = *(const float4*)(q + 8192 + 4);
    const float4 b0 = *(const float4*)(q + 10240), b1 = *(const float4*)(q + 10240 + 4);
    X.r[0] = (f32x2){r0.x, r0.y}; X.r[1] = (f32x2){r0.z, r0.w}; X.r[2] = (f32x2){r1.x, r1.y}; X.r[3] = (f32x2){r1.z, r1.w};
    X.w[0] = (f32x2){w0.x, w0.y}; X.w[1] = (f32x2){w0.z, w0.w}; X.w[2] = (f32x2){w1.x, w1.y}; X.w[3] = (f32x2){w1.z, w1.w};
    X.k[0] = (f32x2){k0.x, k0.y}; X.k[1] = (f32x2){k0.z, k0.w}; X.k[2] = (f32x2){k1.x, k1.y}; X.k[3] = (f32x2){k1.z, k1.w};
    X.a[0] = (f32x2){a0.x, a0.y}; X.a[1] = (f32x2){a0.z, a0.w}; X.a[2] = (f32x2){a1.x, a1.y}; X.a[3] = (f32x2){a1.z, a1.w};
    X.b[0] = (f32x2){b0.x, b0.y}; X.b[1] = (f32x2){b0.z, b0.w}; X.b[2] = (f32x2){b1.x, b1.y}; X.b[3] = (f32x2){b1.z, b1.w};
    X.vv = *(const f32x2*)(buf + 6144 + sl * 64 + 2 * i0);
}
__device__ __forceinline__ void do_step(const StepOps& X, f32x2 (&S0)[4], f32x2 (&S1)[4], float* yl, int sl, int js, int i0) {
    f32x2 t0 = S0[0] * X.a[0], t1 = S1[0] * X.a[0];
#pragma unroll
    for (int e = 1; e < 4; ++e) { t0 = S0[e] * X.a[e] + t0; t1 = S1[e] * X.a[e] + t1; }
    const float sa0 = sum8(t0.x + t0.y), sa1 = sum8(t1.x + t1.y);
#pragma unroll
    for (int e = 0; e < 4; ++e) {
        const f32x2 u0 = X.b[e] * sa0 + X.k[e] * X.vv.x, u1 = X.b[e] * sa1 + X.k[e] * X.vv.y;
        S0[e] = S0[e] * X.w[e] + u0; S1[e] = S1[e] * X.w[e] + u1;
    }
    f32x2 y0 = S0[0] * X.r[0], y1 = S1[0] * X.r[0];
#pragma unroll
    for (int e = 1; e < 4; ++e) { y0 = S0[e] * X.r[e] + y0; y1 = S1[e] * X.r[e] + y1; }
    const float ys0 = sum8(y0.x + y0.y), ys1 = sum8(y1.x + y1.y);
    yl[sl * 64 + i0] = ys0; yl[sl * 64 + i0 + 32] = ys1;
}
__device__ __forceinline__ void step_row(int d, int b, int s, int& row, int& nrow, bool& nv) {
    if (s < CTXL) { const int li = d ? (CTXL - 1 - s) : s; row = TL + b * CTXL + li; nv = d ? (li < CTXL - 1) : (li > 0); }
    else { const int t = d ? (SEQ - 1 - (s - CTXL)) : (s - CTXL); row = b * SEQ + t; nv = d ? (t < SEQ - 1) : (t > 0); }
    nrow = d ? row + 1 : row - 1;
}
__device__ __forceinline__ void mix8(const uint4 z, const uint4 zn, const float* mu, float* o) {
    float a[8], bb[8]; unpack8(z, a); unpack8(zn, bb);
#pragma unroll
    for (int e = 0; e < 8; ++e) o[e] = a[e] + mu[e] * (bb[e] - a[e]);
}

__device__ void scan_head2(const Params& p, int l, int hd, unsigned char* smem) {
    unsigned char* ws = lnd(p.ws);
    const bf16_t* SR = (const bf16_t*)(ws + OFF_SRKV);
    const bf16_t* SL = (const bf16_t*)(ws + OFF_SLORA);
    const int tid = my_tid();
    const int wv = __builtin_amdgcn_readfirstlane(tid >> 6), lane = tid & 63;
    const int d = hd >> 6, b = (hd >> 3) & 7, h = hd & 7;
    bf16_t* BON = (bf16_t*)(ws + OFF_BON) + (size_t)d * TT * 512;
    bf16_t* YO = (bf16_t*)(ws + OFF_Y) + (size_t)d * TT * 512;
    float* bufs = (float*)smem;
    float* yls = bufs + 2 * 12288;
    unsigned char* pscr = smem + 114688;
    float* hp = (float*)(smem + 139264);
    constexpr int NCH = (CTXL + SEQ) / 32;
    __syncthreads();
    if (tid < 64) {
        const float* mu = lnd(p.in[I_MU]) + (size_t)(l * 2 + d) * 1664;
        hp[0 * 64 + tid] = lnd(p.in[I_W0])[(l * 2 + d) * 512 + h * 64 + tid];
        hp[1 * 64 + tid] = lnd(p.in[I_A0])[(l * 2 + d) * 512 + h * 64 + tid];
        hp[2 * 64 + tid] = lnd(p.in[I_KK])[l * 512 + h * 64 + tid];
        hp[3 * 64 + tid] = lnd(p.in[I_KA])[l * 512 + h * 64 + tid];
        hp[4 * 64 + tid] = lnd(p.in[I_RK])[(l * 8 + h) * 64 + tid];
        hp[5 * 64 + tid] = mu[h * 64 + tid];
        hp[6 * 64 + tid] = mu[512 + h * 64 + tid];
        hp[7 * 64 + tid] = mu[1024 + h * 64 + tid];
        hp[8 * 64 + tid] = mu[1536 + tid];
        hp[9 * 64 + tid] = mu[1600 + tid];
    }
    __syncthreads();
    if (wv < 4) {
        const int js = lane & 7, i0 = wv * 8 + (lane >> 3);
        f32x2 S0[4], S1[4];
#pragma unroll
        for (int e = 0; e < 4; ++e) { S0[e] = (f32x2){0.f, 0.f}; S1[e] = (f32x2){0.f, 0.f}; }
        __syncthreads();
        for (int c = 0; c < NCH; ++c) {
            const float* buf = bufs + (c & 1) * 12288; float* yl = yls + (c & 1) * 2048;
            StepOps A0, A1;
            ld_step(A0, buf, 0, js, i0);
            for (int sl = 0; sl < 32; sl += 2) {
                ld_step(A1, buf, sl + 1, js, i0);
                do_step(A0, S0, S1, yl, sl, js, i0);
                ld_step(A0, buf, min(sl + 2, 31), js, i0);
                do_step(A1, S0, S1, yl, sl + 1, js, i0);
            }
            __syncthreads();
        }
    } else {
        const int pw = wv - 4, s8 = lane >> 3, c8 = lane & 7, ql = lane & 15, g4 = lane >> 4;
        bf16_t* tlb = (bf16_t*)(pscr + pw * 6144); bf16_t* lmb = tlb + 512; float* wlf = (float*)(tlb + 1024); float* alf = wlf + 512;
        bf16x8 bw[4][2], ba[4][2];
        {
            const float* w2 = lnd(p.in[I_W2]) + (size_t)(l * 2 + d) * 64 * 512 + h * 64; const float* a2 = lnd(p.in[I_A2]) + (size_t)(l * 2 + d) * 64 * 512 + h * 64;
#pragma unroll
            for (int nt = 0; nt < 4; ++nt)
#pragma unroll
                for (int ks = 0; ks < 2; ++ks) {
                    float fw[8], fa[8];
#pragma unroll
                    for (int jj = 0; jj < 8; ++jj) { const int j = ks * 32 + 8 * g4 + jj; fw[jj] = w2[j * 512 + nt * 16 + ql]; fa[jj] = a2[j * 512 + nt * 16 + ql]; }
                    const uint4 uw = pack8(fw), ua = pack8(fa);
                    bw[nt][ks] = __builtin_bit_cast(bf16x8, uw); ba[nt][ks] = __builtin_bit_cast(bf16x8, ua);
                }
        }
        const f32x4 zero4 = (f32x4){0.f, 0.f, 0.f, 0.f};
        for (int c = -1; c < NCH; ++c) {
            if (c > 0) {
                int row, nrow; bool nv; step_row(d, b, (c - 1) * 32 + 8 * pw + s8, row, nrow, nv);
                const float* yl = yls + ((c - 1) & 1) * 2048 + (8 * pw + s8) * 64 + 8 * c8;
                const float4 y0 = *(const float4*)yl, y1 = *(const float4*)(yl + 4);
                *(uint4*)(YO + (size_t)row * 512 + h * 64 + 8 * c8) = make_uint4(cvtpk(y0.x, y0.y), cvtpk(y0.z, y0.w), cvtpk(y1.x, y1.y), cvtpk(y1.z, y1.w));
            }
            if (c + 1 < NCH) {
                float* buf = bufs + ((c + 1) & 1) * 12288;
                int row, nrow; bool nv; step_row(d, b, (c + 1) * 32 + 8 * pw + s8, row, nrow, nv);
                const uint4 z4 = make_uint4(0u, 0u, 0u, 0u);
                float rm[8], km[8], vm[8];
                {
                    const bf16_t* pl = SL + (size_t)row * 256 + 8 * c8; const bf16_t* pln = SL + (size_t)nrow * 256 + 8 * c8;
                    const uint4 lw = *(const uint4*)pl, la = *(const uint4*)(pl + 64);
                    const uint4 lwn = nv ? *(const uint4*)pln : z4, lan = nv ? *(const uint4*)(pln + 64) : z4;
                    const bf16_t* pr = SR + (size_t)row * 1536 + h * 64 + 8 * c8; const bf16_t* pn = SR + (size_t)nrow * 1536 + h * 64 + 8 * c8;
                    const uint4 r0 = *(const uint4*)pr, k0 = *(const uint4*)(pr + 512), v0 = *(const uint4*)(pr + 1024);
                    const uint4 r1 = nv ? *(const uint4*)pn : z4, k1 = nv ? *(const uint4*)(pn + 512) : z4, v1 = nv ? *(const uint4*)(pn + 1024) : z4;
                    float lwm[8], lam8[8];
                    mix8(lw, lwn, hp + 8 * 64 + 8 * c8, lwm); mix8(la, lan, hp + 9 * 64 + 8 * c8, lam8);
#pragma unroll
                    for (int e = 0; e < 8; ++e) lwm[e] = tanh_fast(lwm[e]);
                    *(uint4*)(tlb + s8 * 64 + 8 * c8) = pack8(lwm); *(uint4*)(lmb + s8 * 64 + 8 * c8) = pack8(lam8);
                    mix8(r0, r1, hp + 5 * 64 + 8 * c8, rm); mix8(k0, k1, hp + 6 * 64 + 8 * c8, km); mix8(v0, v1, hp + 7 * 64 + 8 * c8, vm);
                }
                asm volatile("s_waitcnt lgkmcnt(0)" ::: "memory");
                {
                    const bf16x8 aw0 = *(const bf16x8*)(tlb + (ql & 7) * 64 + 8 * g4), aw1 = *(const bf16x8*)(tlb + (ql & 7) * 64 + 32 + 8 * g4);
                    const bf16x8 aa0 = *(const bf16x8*)(lmb + (ql & 7) * 64 + 8 * g4), aa1 = *(const bf16x8*)(lmb + (ql & 7) * 64 + 32 + 8 * g4);
#pragma unroll
                    for (int nt = 0; nt < 4; ++nt) {
                        f32x4 cw = __builtin_amdgcn_mfma_f32_16x16x32_bf16(aw0, bw[nt][0], zero4, 0, 0, 0); cw = __builtin_amdgcn_mfma_f32_16x16x32_bf16(aw1, bw[nt][1], cw, 0, 0, 0);
                        f32x4 ca = __builtin_amdgcn_mfma_f32_16x16x32_bf16(aa0, ba[nt][0], zero4, 0, 0, 0); ca = __builtin_amdgcn_mfma_f32_16x16x32_bf16(aa1, ba[nt][1], ca, 0, 0, 0);
                        if (g4 < 2) {
#pragma unroll
                            for (int v = 0; v < 4; ++v) { wlf[(4 * g4 + v) * 64 + nt * 16 + ql] = cw[v]; alf[(4 * g4 + v) * 64 + nt * 16 + ql] = ca[v]; }
                        }
                    }
                }
                asm volatile("s_waitcnt lgkmcnt(0)" ::: "memory");
                {
                    float wl[8], al[8];
                    { const float4 x0 = *(const float4*)(wlf + s8 * 64 + 8 * c8), x1 = *(const float4*)(wlf + s8 * 64 + 8 * c8 + 4), y0 = *(const float4*)(alf + s8 * 64 + 8 * c8), y1 = *(const float4*)(alf + s8 * 64 + 8 * c8 + 4);
                      wl[0] = x0.x; wl[1] = x0.y; wl[2] = x0.z; wl[3] = x0.w; wl[4] = x1.x; wl[5] = x1.y; wl[6] = x1.z; wl[7] = x1.w;
                      al[0] = y0.x; al[1] = y0.y; al[2] = y0.z; al[3] = y0.w; al[4] = y1.x; al[5] = y1.y; al[6] = y1.z; al[7] = y1.w; }
                    float dec[8], ag[8], kk[8], kmod[8], ss = 0.f, rk = 0.f;
#pragma unroll
                    for (int e = 0; e < 8; ++e) { const int i = 8 * c8 + e;
                        dec[e] = __expf(-0.60653065971f * sigmoidf_(wl[e] + hp[i]));
                        ag[e] = sigmoidf_(al[e] + hp[64 + i]);
                        kk[e] = km[e] * hp[2 * 64 + i]; ss += kk[e] * kk[e];
                        kmod[e] = km[e] * (1.f + (ag[e] - 1.f) * hp[3 * 64 + i]);
                        rk += rm[e] * kmod[e] * hp[4 * 64 + i]; }
                    ss = sum8(ss); rk = sum8(rk);
                    const float rn = rsqrtf(fmaxf(ss, 1e-24f));
                    float av[8], bv[8], bo[8];
#pragma unroll
                    for (int e = 0; e < 8; ++e) { kk[e] *= rn; av[e] = -kk[e]; bv[e] = kk[e] * ag[e]; bo[e] = rk * vm[e]; }
                    float* q = buf + (8 * pw + s8) * 64 + 8 * c8;
                    *(float4*)(q) = make_float4(rm[0], rm[1], rm[2], rm[3]); *(float4*)(q + 4) = make_float4(rm[4], rm[5], rm[6], rm[7]);
                    *(float4*)(q + 2048) = make_float4(dec[0], dec[1], dec[2], dec[3]); *(float4*)(q + 2048 + 4) = make_float4(dec[4], dec[5], dec[6], dec[7]);
                    *(float4*)(q + 4096) = make_float4(kmod[0], kmod[1], kmod[2], kmod[3]); *(float4*)(q + 4096 + 4) = make_float4(kmod[4], kmod[5], kmod[6], kmod[7]);
                    { float* qv = buf + 6144 + (8 * pw + s8) * 64 + 2 * ((8 * c8) & 31) + (c8 >> 2);
#pragma unroll
                      for (int e = 0; e < 8; ++e) qv[2 * e] = vm[e]; }
                    *(float4*)(q + 8192) = make_float4(av[0], av[1], av[2], av[3]); *(float4*)(q + 8192 + 4) = make_float4(av[4], av[5], av[6], av[7]);
                    *(float4*)(q + 10240) = make_float4(bv[0], bv[1], bv[2], bv[3]); *(float4*)(q + 10240 + 4) = make_float4(bv[4], bv[5], bv[6], bv[7]);
                    *(uint4*)(BON + (size_t)row * 512 + h * 64 + 8 * c8) = pack8(bo);
                }
            }
            __syncthreads();
        }
        {
            int row, nrow; bool nv; step_row(d, b, (NCH - 1) * 32 + 8 * pw + s8, row, nrow, nv);
            const float* yl = yls + ((NCH - 1) & 1) * 2048 + (8 * pw + s8) * 64 + 8 * c8;
            const float4 y0 = *(const float4*)yl, y1 = *(const float4*)(yl + 4);
            *(uint4*)(YO + (size_t)row * 512 + h * 64 + 8 * c8) = make_uint4(cvtpk(y0.x, y0.y), cvtpk(y0.z, y0.w), cvtpk(y1.x, y1.y), cvtpk(y1.z, y1.w));
        }
    }
    __syncthreads();
}


struct StepOps3 { f32x2 a[4], q[4], w[4], k[4], b[4]; float v; f32x2 sc; };
constexpr int SBUF = 12288 + 64;
__device__ __forceinline__ void ld_step3(StepOps3& X, const float* buf, int sl, int js, int irow) {
    const float* q = buf + sl * 64 + 8 * js;
    const float4 q0 = *(const float4*)(q), q1 = *(const float4*)(q + 4);
    const float4 w0 = *(const float4*)(q + 2048), w1 = *(const float4*)(q + 2048 + 4);
    const float4 k0 = *(const float4*)(q + 4096), k1 = *(const float4*)(q + 4096 + 4);
    const float4 a0 = *(const float4*)(q + 8192), a1 = *(const float4*)(q + 8192 + 4);
    const float4 b0 = *(const float4*)(q + 10240), b1 = *(const float4*)(q + 10240 + 4);
    X.q[0] = (f32x2){q0.x, q0.y}; X.q[1] = (f32x2){q0.z, q0.w}; X.q[2] = (f32x2){q1.x, q1.y}; X.q[3] = (f32x2){q1.z, q1.w};
    X.w[0] = (f32x2){w0.x, w0.y}; X.w[1] = (f32x2){w0.z, w0.w}; X.w[2] = (f32x2){w1.x, w1.y}; X.w[3] = (f32x2){w1.z, w1.w};
    X.k[0] = (f32x2){k0.x, k0.y}; X.k[1] = (f32x2){k0.z, k0.w}; X.k[2] = (f32x2){k1.x, k1.y}; X.k[3] = (f32x2){k1.z, k1.w};
    X.a[0] = (f32x2){a0.x, a0.y}; X.a[1] = (f32x2){a0.z, a0.w}; X.a[2] = (f32x2){a1.x, a1.y}; X.a[3] = (f32x2){a1.z, a1.w};
    X.b[0] = (f32x2){b0.x, b0.y}; X.b[1] = (f32x2){b0.z, b0.w}; X.b[2] = (f32x2){b1.x, b1.y}; X.b[3] = (f32x2){b1.z, b1.w};
    X.v = buf[6144 + sl * 64 + irow];
    X.sc = *(const f32x2*)(buf + 12288 + 2 * sl);
}
__device__ __forceinline__ void do_step3(const StepOps3& X, f32x2 (&S)[4], float* yl, int sl, int i0) {
    f32x2 t0 = S[0] * X.a[0], t1 = S[2] * X.a[2], u0 = S[0] * X.q[0], u1 = S[2] * X.q[2];
    t0 = S[1] * X.a[1] + t0; t1 = S[3] * X.a[3] + t1; u0 = S[1] * X.q[1] + u0; u1 = S[3] * X.q[3] + u1;
    t0 = t0 + t1; u0 = u0 + u1;
    f32x2 pre[4];
#pragma unroll
    for (int e = 0; e < 4; ++e) pre[e] = S[e] * X.w[e] + X.k[e] * X.v;
    const float sa = sum8(t0.x + t0.y), yq = sum8(u0.x + u0.y);
#pragma unroll
    for (int e = 0; e < 4; ++e) S[e] = X.b[e] * sa + pre[e];
    yl[sl * 32 + i0] = yq + sa * X.sc.x + X.v * X.sc.y;
}
struct RawStep { f32x4 q0, q1, w0, w1, k0, k1, a0, a1, b0, b1; float v; f32x2 sc; };
__device__ __forceinline__ void ld_rawstep(RawStep& R, unsigned aq, unsigned av, unsigned asc) {
    asm volatile("ds_read_b128 %0, %1" : "=v"(R.q0) : "v"(aq));
    asm volatile("ds_read_b128 %0, %1 offset:16" : "=v"(R.q1) : "v"(aq));
    asm volatile("ds_read_b128 %0, %1 offset:8192" : "=v"(R.w0) : "v"(aq));
    asm volatile("ds_read_b128 %0, %1 offset:8208" : "=v"(R.w1) : "v"(aq));
    asm volatile("ds_read_b128 %0, %1 offset:16384" : "=v"(R.k0) : "v"(aq));
    asm volatile("ds_read_b128 %0, %1 offset:16400" : "=v"(R.k1) : "v"(aq));
    asm volatile("ds_read_b128 %0, %1 offset:32768" : "=v"(R.a0) : "v"(aq));
    asm volatile("ds_read_b128 %0, %1 offset:32784" : "=v"(R.a1) : "v"(aq));
    asm volatile("ds_read_b128 %0, %1 offset:40960" : "=v"(R.b0) : "v"(aq));
    asm volatile("ds_read_b128 %0, %1 offset:40976" : "=v"(R.b1) : "v"(aq));
    asm volatile("ds_read_b32 %0, %1" : "=v"(R.v) : "v"(av));
    asm volatile("ds_read_b64 %0, %1" : "=v"(R.sc) : "v"(asc));
}
__device__ __forceinline__ void wait_rawstep(RawStep& R) {
    asm volatile("s_waitcnt lgkmcnt(12)" : "+v"(R.q0), "+v"(R.q1), "+v"(R.w0), "+v"(R.w1), "+v"(R.k0), "+v"(R.k1), "+v"(R.a0), "+v"(R.a1), "+v"(R.b0), "+v"(R.b1), "+v"(R.v), "+v"(R.sc));
}
__device__ __forceinline__ void cvt_rawstep(const RawStep& R, StepOps3& X) {
    X.q[0] = (f32x2){R.q0[0], R.q0[1]}; X.q[1] = (f32x2){R.q0[2], R.q0[3]}; X.q[2] = (f32x2){R.q1[0], R.q1[1]}; X.q[3] = (f32x2){R.q1[2], R.q1[3]};
    X.w[0] = (f32x2){R.w0[0], R.w0[1]}; X.w[1] = (f32x2){R.w0[2], R.w0[3]}; X.w[2] = (f32x2){R.w1[0], R.w1[1]}; X.w[3] = (f32x2){R.w1[2], R.w1[3]};
    X.k[0] = (f32x2){R.k0[0], R.k0[1]}; X.k[1] = (f32x2){R.k0[2], R.k0[3]}; X.k[2] = (f32x2){R.k1[0], R.k1[1]}; X.k[3] = (f32x2){R.k1[2], R.k1[3]};
    X.a[0] = (f32x2){R.a0[0], R.a0[1]}; X.a[1] = (f32x2){R.a0[2], R.a0[3]}; X.a[2] = (f32x2){R.a1[0], R.a1[1]}; X.a[3] = (f32x2){R.a1[2], R.a1[3]};
    X.b[0] = (f32x2){R.b0[0], R.b0[1]}; X.b[1] = (f32x2){R.b0[2], R.b0[3]}; X.b[2] = (f32x2){R.b1[0], R.b1[1]}; X.b[3] = (f32x2){R.b1[2], R.b1[3]};
    X.v = R.v; X.sc = R.sc;
}
struct RawIn { uint4 lw, la, lwn, lan, r0, k0, v0, r1, k1, v1; int row; };
__device__ __forceinline__ void load_raw(RawIn& R, const bf16_t* SR, const bf16_t* SL, int d, int b, int h, int s, int c8) {
    int row, nrow; bool nv; step_row(d, b, s, row, nrow, nv);
    const int nr = nv ? nrow : row; const unsigned m = nv ? 0xffffffffu : 0u;
    const bf16_t* pl = SL + (size_t)row * 256 + 8 * c8; const bf16_t* pln = SL + (size_t)nr * 256 + 8 * c8;
    R.lw = *(const uint4*)pl; R.la = *(const uint4*)(pl + 64);
    R.lwn = *(const uint4*)pln; R.lan = *(const uint4*)(pln + 64);
    const bf16_t* pr = SR + (size_t)row * 1536 + h * 64 + 8 * c8; const bf16_t* pn = SR + (size_t)nr * 1536 + h * 64 + 8 * c8;
    R.r0 = *(const uint4*)pr; R.k0 = *(const uint4*)(pr + 512); R.v0 = *(const uint4*)(pr + 1024);
    R.r1 = *(const uint4*)pn; R.k1 = *(const uint4*)(pn + 512); R.v1 = *(const uint4*)(pn + 1024);
    R.lwn.x &= m; R.lwn.y &= m; R.lwn.z &= m; R.lwn.w &= m; R.lan.x &= m; R.lan.y &= m; R.lan.z &= m; R.lan.w &= m;
    R.r1.x &= m; R.r1.y &= m; R.r1.z &= m; R.r1.w &= m; R.k1.x &= m; R.k1.y &= m; R.k1.z &= m; R.k1.w &= m; R.v1.x &= m; R.v1.y &= m; R.v1.z &= m; R.v1.w &= m;
    R.row = row;
}
template <int MODE> __device__ void scan_head3(const Params& p, int l, int item, unsigned char* smem) {
    unsigned char* ws = lnd(p.ws);
    const bf16_t* SR = (const bf16_t*)(ws + OFF_SRKV);
    const bf16_t* SL = (const bf16_t*)(ws + OFF_SLORA);
    const int tid = my_tid();
    const int wv = __builtin_amdgcn_readfirstlane(tid >> 6), lane = tid & 63;
    const int hd = item >> 1, half = item & 1;
    const int d = hd >> 6, b = (hd >> 3) & 7, h = hd & 7;
    bf16_t* BON = (bf16_t*)(ws + OFF_BON) + (size_t)d * TT * 512;
    bf16_t* YO = (bf16_t*)(ws + OFF_Y) + (size_t)d * TT * 512;
    float* bufs = (float*)smem;
    float* yls = bufs + 2 * SBUF;
    unsigned char* pscr = smem + (2 * SBUF + 2048) * 4;
    float* hp = (float*)(pscr + 4 * 6144);
    constexpr int NCH = (CTXL + SEQ) / 32;
    __syncthreads();
    if (tid < 64) {
        const float* mu = lnd(p.in[I_MU]) + (size_t)(l * 2 + d) * 1664;
        hp[0 * 64 + tid] = lnd(p.in[I_W0])[(l * 2 + d) * 512 + h * 64 + tid];
        hp[1 * 64 + tid] = lnd(p.in[I_A0])[(l * 2 + d) * 512 + h * 64 + tid];
        hp[2 * 64 + tid] = lnd(p.in[I_KK])[l * 512 + h * 64 + tid];
        hp[3 * 64 + tid] = lnd(p.in[I_KA])[l * 512 + h * 64 + tid];
        hp[4 * 64 + tid] = lnd(p.in[I_RK])[(l * 8 + h) * 64 + tid];
        hp[5 * 64 + tid] = mu[h * 64 + tid];
        hp[6 * 64 + tid] = mu[512 + h * 64 + tid];
        hp[7 * 64 + tid] = mu[1024 + h * 64 + tid];
        hp[8 * 64 + tid] = mu[1536 + tid];
        hp[9 * 64 + tid] = mu[1600 + tid];
    }
    __syncthreads();
    if (wv < 4) {
        const int js = lane & 7, i0 = wv * 8 + (lane >> 3), irow = 32 * half + i0;
        f32x2 S[4];
#pragma unroll
        for (int e = 0; e < 4; ++e) S[e] = (f32x2){0.f, 0.f};
        __syncthreads();
        for (int c = 0; c < NCH; ++c) {
            const float* buf = bufs + (c & 1) * SBUF; float* yl = yls + (c & 1) * 1024;
            if (MODE != 2) {
            const unsigned lb = (unsigned)(size_t)(PG8_LAS const float*)buf;
            const unsigned aq = lb + 32u * js, av = lb + 6144u * 4u + 4u * irow, asc = lb + 12288u * 4u;
            RawStep R0, R1; StepOps3 X;
            ld_rawstep(R0, aq, av, asc);
            for (int sl = 0; sl < 32; sl += 2) {
                ld_rawstep(R1, aq + 256u * (sl + 1), av + 256u * (sl + 1), asc + 8u * (sl + 1)); __builtin_amdgcn_sched_barrier(0);
                wait_rawstep(R0); cvt_rawstep(R0, X); do_step3(X, S, yl, sl, i0); __builtin_amdgcn_sched_barrier(0);
                const int s2 = min(sl + 2, 31);
                ld_rawstep(R0, aq + 256u * s2, av + 256u * s2, asc + 8u * s2); __builtin_amdgcn_sched_barrier(0);
                wait_rawstep(R1); cvt_rawstep(R1, X); do_step3(X, S, yl, sl + 1, i0); __builtin_amdgcn_sched_barrier(0);
            }
            asm volatile("s_waitcnt lgkmcnt(0)" ::: "memory");
            }
            __syncthreads();
        }
    } else {
        const int pw = wv - 4, s8 = lane >> 3, c8 = lane & 7, ql = lane & 15, g4 = lane >> 4;
        bf16_t* tlb = (bf16_t*)(pscr + pw * 6144); bf16_t* lmb = tlb + 512; float* wlf = (float*)(tlb + 1024); float* alf = wlf + 512;
        bf16x8 bw[4][2], ba[4][2];
        {
            const float* w2 = lnd(p.in[I_W2]) + (size_t)(l * 2 + d) * 64 * 512 + h * 64; const float* a2 = lnd(p.in[I_A2]) + (size_t)(l * 2 + d) * 64 * 512 + h * 64;
#pragma unroll
            for (int nt = 0; nt < 4; ++nt)
#pragma unroll
                for (int ks = 0; ks < 2; ++ks) {
                    float fw[8], fa[8];
#pragma unroll
                    for (int jj = 0; jj < 8; ++jj) { const int j = ks * 32 + 8 * g4 + jj; fw[jj] = w2[j * 512 + nt * 16 + ql]; fa[jj] = a2[j * 512 + nt * 16 + ql]; }
                    const uint4 uw = pack8(fw), ua = pack8(fa);
                    bw[nt][ks] = __builtin_bit_cast(bf16x8, uw); ba[nt][ks] = __builtin_bit_cast(bf16x8, ua);
                }
        }
        const f32x4 zero4 = (f32x4){0.f, 0.f, 0.f, 0.f};
        RawIn RC; load_raw(RC, SR, SL, d, b, h, 8 * pw + s8, c8);
        for (int c = -1; c <= NCH; ++c) {
            if (c > 0 && (c8 >> 2) == half) {
                int row, nrow; bool nv; step_row(d, b, (c - 1) * 32 + 8 * pw + s8, row, nrow, nv);
                const float* yl = yls + ((c - 1) & 1) * 1024 + (8 * pw + s8) * 32 + 8 * (c8 & 3);
                const float4 y0 = *(const float4*)yl, y1 = *(const float4*)(yl + 4);
                *(uint4*)(YO + (size_t)row * 512 + h * 64 + 8 * c8) = make_uint4(cvtpk(y0.x, y0.y), cvtpk(y0.z, y0.w), cvtpk(y1.x, y1.y), cvtpk(y1.z, y1.w));
            }
            if (c == NCH) break;
            if (c + 1 < NCH && (MODE != 1 || c < 1)) {
                float* buf = bufs + ((c + 1) & 1) * SBUF;
                RawIn RN = RC;
                if (c + 2 < NCH) load_raw(RN, SR, SL, d, b, h, (c + 2) * 32 + 8 * pw + s8, c8);
                const int row = RC.row;
                float rm[8], km[8], vm[8];
                {
                    const uint4 lw = RC.lw, la = RC.la, lwn = RC.lwn, lan = RC.lan, r0 = RC.r0, k0 = RC.k0, v0 = RC.v0, r1 = RC.r1, k1 = RC.k1, v1 = RC.v1;
                    float lwm[8], lam8[8];
                    mix8(lw, lwn, hp + 8 * 64 + 8 * c8, lwm); mix8(la, lan, hp + 9 * 64 + 8 * c8, lam8);
#pragma unroll
                    for (int e = 0; e < 8; ++e) lwm[e] = tanh_fast(lwm[e]);
                    *(uint4*)(tlb + s8 * 64 + 8 * c8) = pack8(lwm); *(uint4*)(lmb + s8 * 64 + 8 * c8) = pack8(lam8);
                    mix8(r0, r1, hp + 5 * 64 + 8 * c8, rm); mix8(k0, k1, hp + 6 * 64 + 8 * c8, km); mix8(v0, v1, hp + 7 * 64 + 8 * c8, vm);
                }
                asm volatile("s_waitcnt lgkmcnt(0)" ::: "memory");
                {
                    const bf16x8 aw0 = *(const bf16x8*)(tlb + (ql & 7) * 64 + 8 * g4), aw1 = *(const bf16x8*)(tlb + (ql & 7) * 64 + 32 + 8 * g4);
                    const bf16x8 aa0 = *(const bf16x8*)(lmb + (ql & 7) * 64 + 8 * g4), aa1 = *(const bf16x8*)(lmb + (ql & 7) * 64 + 32 + 8 * g4);
#pragma unroll
                    for (int nt = 0; nt < 4; ++nt) {
                        f32x4 cw = __builtin_amdgcn_mfma_f32_16x16x32_bf16(aw0, bw[nt][0], zero4, 0, 0, 0); cw = __builtin_amdgcn_mfma_f32_16x16x32_bf16(aw1, bw[nt][1], cw, 0, 0, 0);
                        f32x4 ca = __builtin_amdgcn_mfma_f32_16x16x32_bf16(aa0, ba[nt][0], zero4, 0, 0, 0); ca = __builtin_amdgcn_mfma_f32_16x16x32_bf16(aa1, ba[nt][1], ca, 0, 0, 0);
                        if (g4 < 2) {
#pragma unroll
                            for (int v = 0; v < 4; ++v) { wlf[(4 * g4 + v) * 64 + nt * 16 + ql] = cw[v]; alf[(4 * g4 + v) * 64 + nt * 16 + ql] = ca[v]; }
                        }
                    }
                }
                asm volatile("s_waitcnt lgkmcnt(0)" ::: "memory");
                {
                    float wl[8], al[8];
                    { const float4 x0 = *(const float4*)(wlf + s8 * 64 + 8 * c8), x1 = *(const float4*)(wlf + s8 * 64 + 8 * c8 + 4), y0 = *(const float4*)(alf + s8 * 64 + 8 * c8), y1 = *(const float4*)(alf + s8 * 64 + 8 * c8 + 4);
                      wl[0] = x0.x; wl[1] = x0.y; wl[2] = x0.z; wl[3] = x0.w; wl[4] = x1.x; wl[5] = x1.y; wl[6] = x1.z; wl[7] = x1.w;
                      al[0] = y0.x; al[1] = y0.y; al[2] = y0.z; al[3] = y0.w; al[4] = y1.x; al[5] = y1.y; al[6] = y1.z; al[7] = y1.w; }
                    float dec[8], ag[8], kk[8], kmod[8], ss = 0.f, rk = 0.f, kr = 0.f;
#pragma unroll
                    for (int e = 0; e < 8; ++e) { const int i = 8 * c8 + e;
                        dec[e] = __expf(-0.60653065971f * sigmoidf_(wl[e] + hp[i]));
                        ag[e] = sigmoidf_(al[e] + hp[64 + i]);
                        kk[e] = km[e] * hp[2 * 64 + i]; ss += kk[e] * kk[e];
                        kmod[e] = km[e] * (1.f + (ag[e] - 1.f) * hp[3 * 64 + i]);
                        rk += rm[e] * kmod[e] * hp[4 * 64 + i]; kr += rm[e] * kmod[e]; }
                    ss = sum8(ss); rk = sum8(rk); kr = sum8(kr);
                    const float rn = rsqrtf(fmaxf(ss, 1e-24f));
                    float av[8], bv[8], bo[8], wr[8], br = 0.f;
#pragma unroll
                    for (int e = 0; e < 8; ++e) { kk[e] *= rn; av[e] = -kk[e]; bv[e] = kk[e] * ag[e]; bo[e] = rk * vm[e]; wr[e] = dec[e] * rm[e]; br += bv[e] * rm[e]; }
                    br = sum8(br);
                    float* q = buf + (8 * pw + s8) * 64 + 8 * c8;
                    *(float4*)(q) = make_float4(wr[0], wr[1], wr[2], wr[3]); *(float4*)(q + 4) = make_float4(wr[4], wr[5], wr[6], wr[7]);
                    *(float4*)(q + 2048) = make_float4(dec[0], dec[1], dec[2], dec[3]); *(float4*)(q + 2048 + 4) = make_float4(dec[4], dec[5], dec[6], dec[7]);
                    *(float4*)(q + 4096) = make_float4(kmod[0], kmod[1], kmod[2], kmod[3]); *(float4*)(q + 4096 + 4) = make_float4(kmod[4], kmod[5], kmod[6], kmod[7]);
                    *(float4*)(q + 6144) = make_float4(vm[0], vm[1], vm[2], vm[3]); *(float4*)(q + 6144 + 4) = make_float4(vm[4], vm[5], vm[6], vm[7]);
                    *(float4*)(q + 8192) = make_float4(av[0], av[1], av[2], av[3]); *(float4*)(q + 8192 + 4) = make_float4(av[4], av[5], av[6], av[7]);
                    *(float4*)(q + 10240) = make_float4(bv[0], bv[1], bv[2], bv[3]); *(float4*)(q + 10240 + 4) = make_float4(bv[4], bv[5], bv[6], bv[7]);
                    if (c8 == 0) *(f32x2*)(buf + 12288 + 2 * (8 * pw + s8)) = (f32x2){br, kr};
                    if (half == 0) *(uint4*)(BON + (size_t)row * 512 + h * 64 + 8 * c8) = pack8(bo);
                }
                RC = RN;
            }
            __syncthreads();
        }
    }
    __syncthreads();
}

__device__ void phase_readout(const Params& p, int l) {
    unsigned char* ws = lnd(p.ws);
    const bf16_t* Y0 = (const bf16_t*)(ws + OFF_Y); const bf16_t* Y1 = Y0 + (size_t)TT * 512;
    const bf16_t* B0 = (const bf16_t*)(ws + OFF_BON); const bf16_t* B1 = B0 + (size_t)TT * 512;
    bf16_t* BR1 = (bf16_t*)(ws + OFF_BR + SZ_BR1);
    const float* lg = lnd(p.in[I_LNXG]) + l * 512; const float* lb = lnd(p.in[I_LNXB]) + l * 512;
    const size_t gt = (size_t)my_bid() * 512 + my_tid(), gn = (size_t)my_nb() * 512;
    for (size_t idx = gt; idx < (size_t)TT * 128; idx += gn) {
        const size_t off = idx * 4; const int c = (int)(off & 511);
        const uint2 ya = *(const uint2*)(Y0 + off), yb = *(const uint2*)(Y1 + off), ba = *(const uint2*)(B0 + off), bb = *(const uint2*)(B1 + off), gg = *(const uint2*)(BR1 + off);
        float y[4] = {bflo(ya.x) + bflo(yb.x), bfhi(ya.x) + bfhi(yb.x), bflo(ya.y) + bflo(yb.y), bfhi(ya.y) + bfhi(yb.y)};
        const float bon[4] = {bflo(ba.x) + bflo(bb.x), bfhi(ba.x) + bfhi(bb.x), bflo(ba.y) + bflo(bb.y), bfhi(ba.y) + bfhi(bb.y)};
        const float gt4[4] = {bflo(gg.x), bfhi(gg.x), bflo(gg.y), bfhi(gg.y)};
        const float mean = sum16(y[0] + y[1] + y[2] + y[3]) * (1.f / 64.f);
        float vs = 0.f;
#pragma unroll
        for (int e = 0; e < 4; ++e) { y[e] -= mean; vs += y[e] * y[e]; }
        const float rs = rsqrtf(sum16(vs) * (1.f / 64.f) + 64e-5f);
        float o[4];
#pragma unroll
        for (int e = 0; e < 4; ++e) o[e] = (y[e] * rs * lg[c + e] + lb[c + e] + bon[e]) * gt4[e];
        *(uint2*)(BR1 + off) = make_uint2(cvtpk(o[0], o[1]), cvtpk(o[2], o[3]));
    }
}

constexpr int NPH_LAYER = 12, NPHASE = 2 + NLAYER * NPH_LAYER;

__device__ void run_phase(const Params& p, int ph, unsigned char* smem) {
    unsigned char* ws = lnd(p.ws);
    float* lds = (float*)smem;
    const float* mod0 = (const float*)(ws + OFF_MOD);
    if (ph == 0) { prologue_mods(p, lds); __syncthreads(); convert_weights(p, 0, lds); return; }
    if (ph == 1) { rowwise(p, lnd(p.in[I_X]), lnd(p.in[I_CTX]), nullptr, nullptr, nullptr, nullptr, nullptr, 0, (bf16_t*)(ws + OFF_HX), lnd(p.in[I_NORMG]) + 0, mod0, 0, 1); return; }
#ifdef PROBE_MODE
    if (ph >= 100) { for (int it = my_bid(); it < 256; it += my_nb()) scan_head3<PROBE_MODE>(p, 1, it, smem); return; }
#endif
    const int l = (ph - 2) / NPH_LAYER, sq = (ph - 2) % NPH_LAYER;
    const int st = sq < 2 ? sq : (sq == 2 ? 3 : (sq == 3 ? 12 : sq));
    const float* modl = mod0 + (size_t)l * 9 * 6144;
    const float* ng = lnd(p.in[I_NORMG]) + (size_t)l * 4 * 1024;
    const float* xs_lat = l == 0 ? lnd(p.in[I_X]) : lnd(p.out); const float* xs_ctx = l == 0 ? lnd(p.in[I_CTX]) : (const float*)(ws + OFF_CTXRES);
    float* ctxres = (float*)(ws + OFF_CTXRES);
    const int G = my_nb(), c = my_bid();
    switch (st) {
    case 0: run_gemm(smem, (const bf16_t*)(ws + OFF_HX), 1024, (const bf16_t*)(ws + OFF_BTIN), NPROJ, 1024, 1 << 20, 0, FProj{ws}, G, c); break;
    case 1: phase_elem(p, l); phase_vt(p, lds); break;
    case 3: phase_attn(p, l, lds, c, G);
            run_gemm(smem, (const bf16_t*)(ws + OFF_SLORA), 256, (const bf16_t*)(ws + OFF_BTG2), 512, 256, 1 << 20, 0, FPlain{(bf16_t*)(ws + OFF_BR + SZ_BR1), 512}, G, c); break;
    case 12: for (int it = c; it < 256; it += G) scan_head3<0>(p, l, it, smem); break;
    case 4: phase_readout(p, l);
            rowwise(p, xs_lat, xs_ctx, nullptr, nullptr, nullptr, nullptr, nullptr, 0, (bf16_t*)(ws + OFF_HXB), ng, modl, 0, 1); break;
    case 5: run_gemm(smem, (const bf16_t*)(ws + OFF_HXB), 1024, (const bf16_t*)(ws + OFF_BTIN) + (size_t)NPROJ * 1024, 3072, 1024, 1 << 20, 0, FSig{(bf16_t*)(ws + OFF_G), 3072}, G, c); break;
    case 6: run_gemm(smem, (const bf16_t*)(ws + OFF_BR), 512, (const bf16_t*)(ws + OFF_BTUP), 3072, 512, 4, SZ_BR1, FMulG{(bf16_t*)(ws + OFF_G), 3072}, G, c); break;
    case 7: run_gemm(smem, (const bf16_t*)(ws + OFF_G), 3072, (const bf16_t*)(ws + OFF_BTO3), 1024, 3072, 1 << 20, 0, FPlain{(bf16_t*)(ws + OFF_HX), 1024}, G, c); break;
    case 8: rowwise(p, xs_lat, xs_ctx, lnd(p.out), ctxres, (const bf16_t*)(ws + OFF_HX), ng + 1024, modl, 2, (bf16_t*)(ws + OFF_HX), ng + 2048, modl, 3, 4); break;
    case 9: run_gemm(smem, (const bf16_t*)(ws + OFF_HX), 1024, (const bf16_t*)(ws + OFF_BTF1), 2 * DFF, 1024, 1 << 20, 0, FSwiglu{(bf16_t*)(ws + OFF_H)}, G, c); break;
    case 10: run_gemm(smem, (const bf16_t*)(ws + OFF_H), DFF, (const bf16_t*)(ws + OFF_BTF2), 1024, DFF, 1 << 20, 0, FPlain{(bf16_t*)(ws + OFF_BR), 1024}, G, c); break;
    case 11:
        if (l + 1 < NLAYER) {
            rowwise(p, lnd(p.out), ctxres, lnd(p.out), ctxres, (const bf16_t*)(ws + OFF_BR), ng + 3072, modl, 5, (bf16_t*)(ws + OFF_HX), lnd(p.in[I_NORMG]) + (size_t)(l + 1) * 4 * 1024, modl + 9 * 6144, 0, 1);
            __syncthreads(); convert_weights(p, l + 1, lds);
        } else rowwise(p, lnd(p.out), ctxres, lnd(p.out), ctxres, (const bf16_t*)(ws + OFF_BR), ng + 3072, modl, 5, nullptr, nullptr, nullptr, 0, 0);
        break;
    }
}

__global__ void __launch_bounds__(512, 2) fwd_megakernel(Params p) {
    extern __shared__ __attribute__((aligned(16))) unsigned char smem[];
#ifndef PROBE_REP
#define PROBE_REP 0
#define PROBE_PH 0
#endif
    const int n_it = p.ph_hi + PROBE_REP;
    for (int it = p.ph_lo; it < n_it; ++it) {
        const int ph = it < p.ph_hi ? it : PROBE_PH;
        run_phase(p, ph, smem);
        if (it + 1 < n_it) { cg::this_grid().sync(); }
    }
}

extern "C" void kernel_launch(void* const* d_in, const int* in_sizes, int n_in, void* d_out, int out_size, void* d_ws, size_t ws_size, hipStream_t stream) {
    static int grid = 0;
    if (grid == 0) {
        if (n_in != 25 || ws_size < WS_END) { fprintf(stderr, "kernel_launch: need 25 inputs and %zu bytes of workspace (got %d, %zu)\n", (size_t)WS_END, n_in, ws_size); grid = -1; return; }
        int dev = 0, cus = 0, per_cu = 0;
        (void)hipGetDevice(&dev); (void)hipDeviceGetAttribute(&cus, hipDeviceAttributeMultiprocessorCount, dev);
        if (hipFuncSetAttribute((const void*)fwd_megakernel, hipFuncAttributeMaxDynamicSharedMemorySize, LDS_BYTES) != hipSuccess) { fprintf(stderr, "kernel_launch: hipFuncSetAttribute failed\n"); grid = -1; return; }
        if (hipOccupancyMaxActiveBlocksPerMultiprocessor(&per_cu, (const void*)fwd_megakernel, 512, LDS_BYTES) != hipSuccess || per_cu < 1) { fprintf(stderr, "kernel_launch: occupancy query gave %d\n", per_cu); per_cu = 1; }
        (void)hipGetLastError();
        grid = cus * 1;
    }
    if (grid < 0) return;
    Params p{};
    for (int i = 0; i < 25; ++i) p.in[i] = (const float*)d_in[i];
    p.out = (float*)d_out; p.ws = (unsigned char*)d_ws;
#if MULTI_LAUNCH
    for (int ph = 0; ph < NPHASE; ++ph) { p.ph_lo = ph; p.ph_hi = ph + 1; hipLaunchKernelGGL(fwd_megakernel, dim3(grid), dim3(512), LDS_BYTES, stream, p); }
#else
    p.ph_lo = 0; p.ph_hi = NPHASE;
    void* args[] = {&p};
    hipError_t e = hipLaunchCooperativeKernel((const void*)fwd_megakernel, dim3(grid), dim3(512), args, LDS_BYTES, stream);
    if (e != hipSuccess) fprintf(stderr, "cooperative launch failed: %s (grid %d)\n", hipGetErrorString(e), grid);
#endif
}
```
